# Optimizing an MI355X kernel written in HIP

```python
import jax, jax.numpy as jnp
from jax import lax
import numpy as np

D_MODEL = 1024
BATCH = 8
SEQ = 4096
DEPTH = 2
DEC_BATCH = 4
DEC_SEQ = 4096
PAST_LEN = 128

CHUNK = 128
A_HEADS = 4
A_HEAD_DIM = 128
A_WIDTH = A_HEADS * A_HEAD_DIM
B_WINDOWS = (2, 4, 8, 16)
B_GROUPS = len(B_WINDOWS)
B_GROUP_DIM = 128
B_WIDTH = B_GROUPS * B_GROUP_DIM
AB_IN = 2 * A_WIDTH + B_WIDTH
AB_OUT = A_WIDTH + B_WIDTH
C_WIDTH = D_MODEL
CONV_W = 3
D_FF = -(-8 * D_MODEL // (3 * 256)) * 256
N_AB_LAYERS = (DEPTH + 1) // 2
N_C_LAYERS = DEPTH // 2
EPS = 1e-6

kernel_name = "hybrid_gmlp_pool_shortconv_encoder"


def rmsnorm(x, g):
    xf = x.astype(jnp.float32)
    y = xf * lax.rsqrt(jnp.mean(xf * xf, axis=-1, keepdims=True) + EPS)
    return (y * g.astype(jnp.float32)).astype(x.dtype)


def chunk_spatial_gate(u, v, g_v, w_s, b_s):
    bn, s, _ = v.shape
    n_c = s // CHUNK
    vf = v.reshape(bn, n_c, CHUNK, A_HEADS, A_HEAD_DIM).astype(jnp.float32)
    mu = jnp.mean(vf, axis=-1, keepdims=True)
    var = jnp.mean(jnp.square(vf - mu), axis=-1, keepdims=True)
    vn = ((vf - mu) * lax.rsqrt(var + EPS) * g_v.reshape(A_HEADS, A_HEAD_DIM).astype(jnp.float32)).astype(v.dtype)
    mixed = jnp.einsum('hpq,bcqhd->bcphd', w_s, vn) + jnp.transpose(b_s)[:, :, None]
    return u * mixed.reshape(bn, s, A_WIDTH)


def multiscale_pool(z, w_pool, pool_scale):
    s = z.shape[1]
    pos = jnp.arange(s)
    outs = []
    for gi, w in enumerate(B_WINDOWS):
        h = w // 2
        zg = z[..., gi * B_GROUP_DIM:(gi + 1) * B_GROUP_DIM].astype(jnp.float32)
        cs = jnp.cumsum(jnp.pad(zg, ((0, 0), (h + 1, h), (0, 0))), axis=1)
        win_sum = cs[:, w:w + s] - cs[:, 0:s]
        count = (jnp.minimum(pos + h, s) - jnp.maximum(pos - h, 0)).astype(jnp.float32)
        r = (win_sum / count[None, :, None] - zg).astype(z.dtype)
        outs.append(jnp.einsum('bsc,cd->bsd', r, w_pool[gi]))
    return jnp.concatenate(outs, axis=-1) * pool_scale


def mixer_ab(x, w_in, g_v, w_s, b_s, w_pool, pool_scale, w_out):
    hcomb = jnp.einsum('bsd,de->bse', x, w_in)
    u = jax.nn.gelu(hcomb[..., :A_WIDTH])
    v = jax.nn.gelu(hcomb[..., A_WIDTH:2 * A_WIDTH])
    z = hcomb[..., 2 * A_WIDTH:]
    a = chunk_spatial_gate(u, v, g_v, w_s, b_s)
    b = multiscale_pool(z, w_pool, pool_scale)
    return jnp.einsum('bse,ed->bsd', jnp.concatenate([a, b], axis=-1), w_out)


def mixer_c(x, w_in, conv_w, w_out):
    s = x.shape[1]
    hcomb = jnp.einsum('bsd,de->bse', x, w_in)
    gate_b = hcomb[..., :C_WIDTH]
    gate_c = hcomb[..., C_WIDTH:2 * C_WIDTH]
    hv = hcomb[..., 2 * C_WIDTH:]
    t = jnp.pad(gate_c * hv, ((0, 0), (1, 1), (0, 0)))
    conv = t[:, 0:s] * conv_w[0] + t[:, 1:s + 1] * conv_w[1] + t[:, 2:s + 2] * conv_w[2]
    return jnp.einsum('bse,ed->bsd', gate_b * conv, w_out)


def swiglu(x, w_gate, w_up, w_down):
    hg = jnp.einsum('bsd,df->bsf', x, w_gate)
    hu = jnp.einsum('bsd,df->bsf', x, w_up)
    return jnp.einsum('bsf,fd->bsd', jax.nn.silu(hg) * hu, w_down)


def trunk(x, norm_g, ab_w_in, ab_v_norm_g, ab_w_spatial, ab_b_spatial, ab_w_pool,
          ab_pool_scale, ab_w_out, c_w_in, c_conv_w, c_w_out, ffn_w_gate, ffn_w_up, ffn_w_down):
    for layer in range(DEPTH):
        g = norm_g[layer]
        h = rmsnorm(x, g[0])
        i = layer // 2
        if layer % 2 == 0:
            h = mixer_ab(h, ab_w_in[i], ab_v_norm_g[i], ab_w_spatial[i], ab_b_spatial[i],
                         ab_w_pool[i], ab_pool_scale[i], ab_w_out[i])
        else:
            h = mixer_c(h, c_w_in[i], c_conv_w[i], c_w_out[i])
        x = x + rmsnorm(h, g[1])
        h = swiglu(rmsnorm(x, g[2]), ffn_w_gate[layer], ffn_w_up[layer], ffn_w_down[layer])
        x = x + rmsnorm(h, g[3])
    return x


def setup_inputs(seed: int = 0) -> dict:
    key = jax.random.key(seed)
    ks = jax.random.split(key, 17)
    f32 = jnp.float32
    nrm = lambda k, shape, scale: jax.random.normal(k, shape, f32) * scale
    return {
        "x_prompt": jax.random.normal(ks[0], (BATCH, SEQ, D_MODEL), f32),
        "x_sample": jax.random.normal(ks[1], (DEC_BATCH, DEC_SEQ, D_MODEL), f32),
        "norm_g": 1.0 + nrm(ks[2], (DEPTH, 4, D_MODEL), 0.02),
        "ab_w_in": nrm(ks[3], (N_AB_LAYERS, D_MODEL, AB_IN), D_MODEL ** -0.5),
        "ab_v_norm_g": 1.0 + nrm(ks[4], (N_AB_LAYERS, A_WIDTH), 0.02),
        "ab_w_spatial": nrm(ks[5], (N_AB_LAYERS, A_HEADS, CHUNK, CHUNK), CHUNK ** -0.5),
        "ab_b_spatial": 1.0 + nrm(ks[6], (N_AB_LAYERS, A_HEADS, CHUNK), 0.02),
        "ab_w_pool": nrm(ks[7], (N_AB_LAYERS, B_GROUPS, B_GROUP_DIM, B_GROUP_DIM), B_GROUP_DIM ** -0.5),
        "ab_pool_scale": 1.0 + nrm(ks[8], (N_AB_LAYERS, B_WIDTH), 0.02),
        "ab_w_out": nrm(ks[9], (N_AB_LAYERS, AB_OUT, D_MODEL), AB_OUT ** -0.5),
        "c_w_in": nrm(ks[10], (N_C_LAYERS, D_MODEL, 3 * C_WIDTH), D_MODEL ** -0.5),
        "c_conv_w": nrm(ks[11], (N_C_LAYERS, CONV_W, C_WIDTH), CONV_W ** -0.5),
        "c_w_out": nrm(ks[12], (N_C_LAYERS, C_WIDTH, D_MODEL), C_WIDTH ** -0.5),
        "ffn_w_gate": nrm(ks[13], (DEPTH, D_MODEL, D_FF), D_MODEL ** -0.5),
        "ffn_w_up": nrm(ks[14], (DEPTH, D_MODEL, D_FF), D_MODEL ** -0.5),
        "ffn_w_down": nrm(ks[15], (DEPTH, D_FF, D_MODEL), D_FF ** -0.5),
    }


def reference(x_prompt, x_sample, norm_g, ab_w_in, ab_v_norm_g, ab_w_spatial, ab_b_spatial,
              ab_w_pool, ab_pool_scale, ab_w_out, c_w_in, c_conv_w, c_w_out,
              ffn_w_gate, ffn_w_up, ffn_w_down):
    y_prompt = trunk(x_prompt, norm_g, ab_w_in, ab_v_norm_g, ab_w_spatial, ab_b_spatial, ab_w_pool,
                     ab_pool_scale, ab_w_out, c_w_in, c_conv_w, c_w_out, ffn_w_gate, ffn_w_up, ffn_w_down)
    y_sample = trunk(x_sample, norm_g, ab_w_in, ab_v_norm_g, ab_w_spatial, ab_b_spatial, ab_w_pool,
                     ab_pool_scale, ab_w_out, c_w_in, c_conv_w, c_w_out, ffn_w_gate, ffn_w_up, ffn_w_down)
    return (y_prompt, y_sample)
```

```cpp
#include <hip/hip_runtime.h>
#include <hip/hip_cooperative_groups.h>
#include <cstdio>
#include <cstdint>
namespace cg = cooperative_groups;

namespace pg8 {
#define PG8_LAS __attribute__((address_space(3)))
typedef unsigned short bf16_t;
typedef short bf16x8 __attribute__((ext_vector_type(8)));
typedef float f32x4 __attribute__((ext_vector_type(4)));
typedef unsigned u32x4 __attribute__((ext_vector_type(4)));
typedef unsigned u32x2 __attribute__((ext_vector_type(2)));
constexpr int BM = 256, BK = 64, HALF = 128, HTB = HALF * BK * 2  , STAGE_BYTES = 8 * HTB, NXCD = 8, WGM = 8;

__host__ __device__ __forceinline__ int lds_byte(int r, int c) { const int st = (r >> 4) * 2 + (c >> 5), rr = r & 15, cc = c & 31, ob = rr * 64 + cc * 2; return st * 1024 + (ob ^ (((ob >> 9) & 1) << 5)); }
__host__ __device__ __forceinline__ void stage_rc(int b, int& R, int& C) { const int st = b / 1024, sb = b % 1024, swz = sb ^ (((sb >> 9) & 1) << 5); R = (st >> 1) * 16 + swz / 64; C = (st & 1) * 32 + (swz % 64) / 2; }
__host__ __device__ __forceinline__ int perm32(int rho) { const int n = rho >> 4, i = rho & 15; return 8 * (i >> 2) + 4 * n + (i & 3); }

struct Unit { int pm, pn; };
struct Gemm { const bf16_t* A; const bf16_t* Bt; int M, N, K; };

struct StaticOrder {
    int nM, nN, nwg, G, c;
    __host__ __device__ void init(int M, int N, int G_, int c_) { nM = M / BM; nN = N / BM; nwg = nM * nN; G = G_; c = c_; }
    __host__ __device__ bool next(int i, Unit& u) const {
        const long L = (long)i * G + c; if (L >= nwg) return false;
        int wgid = (int)L; { const int q = nwg / NXCD, r = nwg % NXCD, xcd = wgid % NXCD, off = wgid / NXCD; wgid = (xcd < r ? xcd * (q + 1) : r * (q + 1) + (xcd - r) * q) + off; }
        const int nig = WGM * nN, gid = wgid / nig, fm = gid * WGM, gsz = (nM - fm) < WGM ? (nM - fm) : WGM;
        u.pm = fm + ((wgid % nig) % gsz); u.pn = (wgid % nig) / gsz; return true;
    }
    __device__ __forceinline__ void a_ready(const Unit&) const {}
    __device__ __forceinline__ void done(const Unit&) const {}
};

__device__ __forceinline__ unsigned cvt_pk_bf16(float lo, float hi) { unsigned r; asm volatile("v_cvt_pk_bf16_f32 %0, %1, %2" : "=v"(r) : "v"(lo), "v"(hi)); return r; }
__device__ __forceinline__ u32x4 pack8(const f32x4 v0, const f32x4 v1) { u32x4 w; w.x = cvt_pk_bf16(v0[0], v0[1]); w.y = cvt_pk_bf16(v0[2], v0[3]); w.z = cvt_pk_bf16(v1[0], v1[1]); w.w = cvt_pk_bf16(v1[2], v1[3]); return w; }
__device__ __forceinline__ float gelu_tanh(float x) { const float t = x * (1.0f + 0.044715f * x * x) * (-2.302208198f); return x * __builtin_amdgcn_rcpf(1.0f + __builtin_amdgcn_exp2f(t)); }
__device__ __forceinline__ float silu_f(float x) { return x * __builtin_amdgcn_rcpf(1.0f + __builtin_amdgcn_exp2f(x * (-1.4426950409f))); }
__device__ __forceinline__ f32x4 gelu4(const f32x4 v) { return (f32x4){gelu_tanh(v[0]), gelu_tanh(v[1]), gelu_tanh(v[2]), gelu_tanh(v[3])}; }
__device__ __forceinline__ f32x4 silu4(const f32x4 v) { return (f32x4){silu_f(v[0]), silu_f(v[1]), silu_f(v[2]), silu_f(v[3])}; }

struct EpiAct {
    static constexpr bool PERM = true, AFTER_DRAIN = false;
    bf16_t* O; int ldc; int n_act;
    __device__ __forceinline__ void operator()(const f32x4 (&acc)[2][2][4][2], const Unit& u, int wr, int wc, int fr, int fq) const {
        const int row0 = u.pm * BM + wr * 64 + fr, col0 = u.pn * BM + wc * 32 + 8 * fq; const bool act = u.pn < n_act;
#pragma unroll
        for (int ai = 0; ai < 2; ++ai)
#pragma unroll
            for (int m = 0; m < 4; ++m) { bf16_t* rowp = O + (size_t)(row0 + ai * HALF + m * 16) * ldc + col0;
#pragma unroll
                for (int bj = 0; bj < 2; ++bj) { f32x4 v0 = acc[ai][bj][m][0], v1 = acc[ai][bj][m][1];
                    if (act) { v0 = gelu4(v0); v1 = gelu4(v1); }
                    *(u32x4*)(rowp + bj * HALF) = pack8(v0, v1); } }
    }
};
struct EpiStats {
    static constexpr bool PERM = true, AFTER_DRAIN = false;
    bf16_t* O; float* part;
    __device__ __forceinline__ void operator()(const f32x4 (&acc)[2][2][4][2], const Unit& u, int wr, int wc, int fr, int fq) const {
        const int row0 = u.pm * BM + wr * 64 + fr, col0 = u.pn * BM + wc * 32 + 8 * fq;
#pragma unroll
        for (int ai = 0; ai < 2; ++ai)
#pragma unroll
            for (int m = 0; m < 4; ++m) { const int row = row0 + ai * HALF + m * 16; bf16_t* rowp = O + (size_t)row * 1024 + col0; float s = 0.f;
#pragma unroll
                for (int bj = 0; bj < 2; ++bj) { const f32x4 v0 = acc[ai][bj][m][0], v1 = acc[ai][bj][m][1];
                    s += (v0[0] * v0[0] + v0[1] * v0[1]) + (v0[2] * v0[2] + v0[3] * v0[3]) + (v1[0] * v1[0] + v1[1] * v1[1]) + (v1[2] * v1[2] + v1[3] * v1[3]);
                    *(u32x4*)(rowp + bj * HALF) = pack8(v0, v1); }
                s += __shfl_xor(s, 16); s += __shfl_xor(s, 32);
                if (fq == 0) part[(size_t)row * 16 + u.pn * 4 + wc] = s; }
    }
};
struct EpiSwiglu {
    static constexpr bool PERM = true, AFTER_DRAIN = false;
    bf16_t* O; int ldc;
    __device__ __forceinline__ void operator()(const f32x4 (&acc)[2][2][4][2], const Unit& u, int wr, int wc, int fr, int fq) const {
        const int row0 = u.pm * BM + wr * 64 + fr, col0 = u.pn * HALF + wc * 32 + 8 * fq;
#pragma unroll
        for (int ai = 0; ai < 2; ++ai)
#pragma unroll
            for (int m = 0; m < 4; ++m) { bf16_t* rowp = O + (size_t)(row0 + ai * HALF + m * 16) * ldc + col0;
                const f32x4 v0 = silu4(acc[ai][0][m][0]) * acc[ai][1][m][0], v1 = silu4(acc[ai][0][m][1]) * acc[ai][1][m][1];
                *(u32x4*)rowp = pack8(v0, v1); }
    }
};
struct EpiMulSplit {
    static constexpr bool PERM = true, AFTER_DRAIN = false;
    bf16_t* T; bf16_t* GB;
    __device__ __forceinline__ void operator()(const f32x4 (&acc)[2][2][4][2], const Unit& u, int wr, int wc, int fr, int fq) const {
        const int row0 = u.pm * BM + wr * 64 + fr;
        if (u.pn < 8) { const int col0 = u.pn * HALF + wc * 32 + 8 * fq;
#pragma unroll
            for (int ai = 0; ai < 2; ++ai)
#pragma unroll
                for (int m = 0; m < 4; ++m) { bf16_t* rowp = T + (size_t)(row0 + ai * HALF + m * 16) * 1024 + col0;
                    *(u32x4*)rowp = pack8(acc[ai][0][m][0] * acc[ai][1][m][0], acc[ai][0][m][1] * acc[ai][1][m][1]); }
        } else { const int col0 = (u.pn - 8) * BM + wc * 32 + 8 * fq;
#pragma unroll
            for (int ai = 0; ai < 2; ++ai)
#pragma unroll
                for (int m = 0; m < 4; ++m) { bf16_t* rowp = GB + (size_t)(row0 + ai * HALF + m * 16) * 1024 + col0;
#pragma unroll
                    for (int bj = 0; bj < 2; ++bj) *(u32x4*)(rowp + bj * HALF) = pack8(acc[ai][bj][m][0], acc[ai][bj][m][1]); }
        }
    }
};

template <class Epi, class Sched, bool ALIGN_EPI = false, bool SP2 = false>
__device__ __forceinline__ void gemm_phase(PG8_LAS unsigned char* lds, const Gemm g, const Sched& S, const Epi& E) {
    const int tid = threadIdx.x, wid = __builtin_amdgcn_readfirstlane(tid >> 6), lane = tid & 63, wr = wid >> 2, wc = wid & 3, fr = lane & 15, fq = lane >> 4;
    const int K = g.K, nt = K / BK;
    unsigned voffA[2], voffB[2];
#pragma unroll
    for (int i = 0; i < 2; ++i) { int R, C; stage_rc(tid * 16 + i * 8192, R, C); const int Rb = Epi::PERM ? ((R & ~31) + perm32(R & 31)) : R;
        voffA[i] = (unsigned)(R * K + C) * 2u; voffB[i] = (unsigned)(Rb * K + C) * 2u; }
    const size_t kstep = (size_t)(BK * 2);
    const size_t hstep = (size_t)HALF * K * 2;
    const size_t tstep = 2 * hstep;
    const unsigned ldsw = (unsigned)wid * 1024u;
    const int aoff = lds_byte(wr * 64 + fr, fq * 8), boff = lds_byte(wc * 32 + fr, fq * 8);
#define PG8_SA(b, h) (((b) * 2 + (h)) * HTB)
#define PG8_SB(b, h) ((4 + (b) * 2 + (h)) * HTB)
#define PG8_STAGE(bufoff, gbase, voff) do { _Pragma("unroll") for (int _i = 0; _i < 2; ++_i) \
        __builtin_amdgcn_global_load_lds((const unsigned*)((const char*)(gbase) + (voff)[_i]), (PG8_LAS unsigned*)(lds + (bufoff) + ldsw + _i * 8192), 16, 0, 0); } while (0)
#define PG8_LDA(dst, b, h) do { _Pragma("unroll") for (int m = 0; m < 4; ++m) _Pragma("unroll") for (int k = 0; k < 2; ++k) dst[m][k] = *(const PG8_LAS bf16x8*)(lds + PG8_SA(b, h) + aoff + m * 2048 + k * 1024); } while (0)
#define PG8_LDB(dst, b, h) do { _Pragma("unroll") for (int n = 0; n < 2; ++n) _Pragma("unroll") for (int k = 0; k < 2; ++k) dst[n][k] = *(const PG8_LAS bf16x8*)(lds + PG8_SB(b, h) + boff + n * 2048 + k * 1024); } while (0)
#define PG8_MMA(ai, bj, At, Bt) do { __builtin_amdgcn_s_setprio(1); _Pragma("unroll") for (int m = 0; m < 4; ++m) _Pragma("unroll") for (int n = 0; n < 2; ++n) _Pragma("unroll") for (int k = 0; k < 2; ++k) \
        acc[ai][bj][m][n] = __builtin_amdgcn_mfma_f32_16x16x32_bf16(Bt[n][k], At[m][k], acc[ai][bj][m][n], 0, 0, 0); __builtin_amdgcn_s_setprio(0); } while (0)
#define PG8_WAIT_V(n) asm volatile("s_waitcnt vmcnt(" #n ")" ::: "memory")
#define PG8_WAIT_L(n) asm volatile("s_waitcnt lgkmcnt(" #n ")" ::: "memory")
#define PG8_BAR __builtin_amdgcn_s_barrier()
#define PG8_SCHED __builtin_amdgcn_sched_barrier(0)
    Unit cur, nxt; int ui = 0;
    if (!S.next(0, cur)) return;
    f32x4 acc[2][2][4][2];
#pragma unroll
    for (int a = 0; a < 2; ++a)
#pragma unroll
        for (int b = 0; b < 2; ++b)
#pragma unroll
            for (int m = 0; m < 4; ++m)
#pragma unroll
                for (int n = 0; n < 2; ++n) acc[a][b][m][n] = (f32x4){0.f, 0.f, 0.f, 0.f};
    bf16x8 At[4][2], B0[2][2], B1[2][2];
    const char* cA = (const char*)g.A + (size_t)cur.pm * tstep; const char* cB = (const char*)g.Bt + (size_t)cur.pn * tstep;
    S.a_ready(cur);
    if constexpr (SP2) {
        PG8_STAGE(PG8_SB(0, 0), cB, voffB); PG8_STAGE(PG8_SB(0, 1), cB + hstep, voffB); PG8_STAGE(PG8_SA(0, 0), cA, voffA); PG8_STAGE(PG8_SA(0, 1), cA + hstep, voffA);
        if (wr == 1) PG8_BAR;
        PG8_WAIT_V(2); PG8_BAR;
        PG8_STAGE(PG8_SB(1, 0), cB + kstep, voffB); PG8_STAGE(PG8_SA(1, 0), cA + kstep, voffA); PG8_STAGE(PG8_SB(1, 1), cB + hstep + kstep, voffB);
        PG8_WAIT_V(6); PG8_BAR;
    } else {
        PG8_STAGE(PG8_SB(0, 0), cB, voffB); PG8_STAGE(PG8_SA(0, 0), cA, voffA); PG8_STAGE(PG8_SB(0, 1), cB + hstep, voffB); PG8_STAGE(PG8_SA(0, 1), cA + hstep, voffA);
        if (wr == 1) PG8_BAR;
        PG8_WAIT_V(4); PG8_BAR;
        PG8_STAGE(PG8_SB(1, 0), cB + kstep, voffB); PG8_STAGE(PG8_SA(1, 0), cA + kstep, voffA); PG8_STAGE(PG8_SB(1, 1), cB + hstep + kstep, voffB);
        PG8_WAIT_V(6); PG8_BAR;
    }
    for (;;) {
        const bool has_next = S.next(ui + 1, nxt);
        const char* nA = has_next ? (const char*)g.A + (size_t)nxt.pm * tstep : cA; const char* nB = has_next ? (const char*)g.Bt + (size_t)nxt.pn * tstep : cB;
        for (int t = 0; t < nt; t += 2) {
            const bool last = (t == nt - 2);
            const char* a1 = cA + (size_t)(t + 1) * kstep;
            const char* a2 = last ? nA : cA + (size_t)(t + 2) * kstep; const char* b2 = last ? nB : cB + (size_t)(t + 2) * kstep;
            const char* a3 = a2 + kstep; const char* b3 = b2 + kstep;
            if (last && has_next) S.a_ready(nxt);
            if constexpr (SP2) {
            PG8_LDB(B0, 0, 0); PG8_LDB(B1, 0, 1); PG8_SCHED; PG8_LDA(At, 0, 0); PG8_STAGE(PG8_SA(1, 1), a1 + hstep, voffA);
            PG8_WAIT_V(8); PG8_WAIT_L(0); PG8_BAR; PG8_MMA(0, 0, At, B0); PG8_MMA(0, 1, At, B1); PG8_BAR; PG8_SCHED;
            PG8_LDA(At, 0, 1); PG8_STAGE(PG8_SB(0, 0), b2, voffB); PG8_STAGE(PG8_SB(0, 1), b2 + hstep, voffB); PG8_STAGE(PG8_SA(0, 0), a2, voffA);
            PG8_WAIT_V(8); PG8_WAIT_L(0); PG8_BAR; PG8_MMA(1, 0, At, B0); PG8_MMA(1, 1, At, B1); PG8_BAR; PG8_SCHED;
            PG8_LDB(B0, 1, 0); PG8_LDB(B1, 1, 1); PG8_SCHED; PG8_LDA(At, 1, 0); PG8_STAGE(PG8_SA(0, 1), a2 + hstep, voffA);
            PG8_WAIT_V(8); PG8_WAIT_L(0); PG8_BAR; PG8_MMA(0, 0, At, B0); PG8_MMA(0, 1, At, B1); PG8_BAR; PG8_SCHED;
            PG8_LDA(At, 1, 1); PG8_STAGE(PG8_SB(1, 0), b3, voffB); PG8_STAGE(PG8_SB(1, 1), b3 + hstep, voffB); PG8_STAGE(PG8_SA(1, 0), a3, voffA);
            PG8_WAIT_V(8); PG8_WAIT_L(0); PG8_BAR; PG8_MMA(1, 0, At, B0); PG8_MMA(1, 1, At, B1); PG8_BAR; PG8_SCHED;
            } else {
            PG8_LDB(B0, 0, 0); PG8_SCHED; PG8_LDA(At, 0, 0); PG8_STAGE(PG8_SA(1, 1), a1 + hstep, voffA);
            PG8_WAIT_L(8); PG8_BAR; PG8_WAIT_L(0); PG8_MMA(0, 0, At, B0); PG8_BAR; PG8_SCHED;
            PG8_LDB(B1, 0, 1); PG8_STAGE(PG8_SB(0, 0), b2, voffB);
            PG8_BAR; PG8_WAIT_L(0); PG8_MMA(0, 1, At, B1); PG8_BAR;
            PG8_LDA(At, 0, 1); PG8_STAGE(PG8_SA(0, 0), a2, voffA);
            PG8_BAR; PG8_WAIT_L(0); PG8_MMA(1, 0, At, B0); PG8_BAR; PG8_SCHED;
            PG8_STAGE(PG8_SB(0, 1), b2 + hstep, voffB);
            PG8_WAIT_V(6); PG8_BAR; PG8_MMA(1, 1, At, B1); PG8_BAR;
            PG8_LDB(B0, 1, 0); PG8_SCHED; PG8_LDA(At, 1, 0); PG8_STAGE(PG8_SA(0, 1), a2 + hstep, voffA);
            PG8_WAIT_L(8); PG8_BAR; PG8_WAIT_L(0); PG8_MMA(0, 0, At, B0); PG8_BAR; PG8_SCHED;
            PG8_LDB(B1, 1, 1); PG8_STAGE(PG8_SB(1, 0), b3, voffB);
            PG8_BAR; PG8_WAIT_L(0); PG8_MMA(0, 1, At, B1); PG8_BAR;
            PG8_LDA(At, 1, 1); PG8_STAGE(PG8_SA(1, 0), a3, voffA);
            PG8_BAR; PG8_WAIT_L(0); PG8_MMA(1, 0, At, B0); PG8_BAR; PG8_SCHED;
            PG8_STAGE(PG8_SB(1, 1), b3 + hstep, voffB);
            PG8_WAIT_V(6); PG8_BAR; PG8_MMA(1, 1, At, B1); PG8_BAR;
            }
        }
        if constexpr (ALIGN_EPI) { if (wr == 0) PG8_BAR; }
        if constexpr (!Epi::AFTER_DRAIN) { E(acc, cur, wr, wc, fr, fq); S.done(cur); }
        if (!has_next) break;
#pragma unroll
        for (int a = 0; a < 2; ++a)
#pragma unroll
            for (int b = 0; b < 2; ++b)
#pragma unroll
                for (int m = 0; m < 4; ++m)
#pragma unroll
                    for (int n = 0; n < 2; ++n) acc[a][b][m][n] = (f32x4){0.f, 0.f, 0.f, 0.f};
        cur = nxt; cA = nA; cB = nB; ++ui;
        if constexpr (ALIGN_EPI) { if (wr == 1) PG8_BAR; }
    }
    PG8_WAIT_V(0);
    if constexpr (!ALIGN_EPI) { if (wr == 0) PG8_BAR; }
    PG8_BAR;
#undef PG8_SA
#undef PG8_SB
#undef PG8_STAGE
#undef PG8_LDA
#undef PG8_LDB
#undef PG8_MMA
#undef PG8_WAIT_V
#undef PG8_WAIT_L
#undef PG8_BAR
#undef PG8_SCHED
}
}

constexpr int D = 1024, SEQ = 4096, MP = 8 * SEQ, MS = 4 * SEQ, M = MP + MS;
constexpr int AB_IN = 1536, FF = 2816, CIN = 3072;
constexpr float EPS = 1e-6f;
constexpr int NWAVES = 8, NTHR = 512;

constexpr size_t MiB = 1u << 20;
constexpr size_t WS_WSB = 1 * MiB, WS_WPT = 1 * MiB + 128 * 1024;
constexpr size_t WS_W1 = 2 * MiB, WS_WO0 = 5 * MiB, WS_WGU0 = 7 * MiB, WS_WD0 = 18 * MiB, WS_WCI = 24 * MiB, WS_WCO = 30 * MiB, WS_WGU1 = 32 * MiB, WS_WD1 = 43 * MiB;
constexpr size_t WS_PART = 49 * MiB;
constexpr size_t WS_HF = 52 * MiB;
constexpr size_t WS_HC = WS_HF, WS_T = WS_HF, WS_GB = WS_HF + 96 * MiB;
constexpr size_t WS_HN = 316 * MiB;
constexpr size_t WS_MB = 412 * MiB;
constexpr size_t WS_END = 508 * MiB;
static_assert(WS_WD1 + (size_t)D * FF * 2 <= WS_PART && WS_PART + (size_t)M * 64 <= WS_HF && WS_HF + (size_t)M * FF * 2 <= WS_HN && WS_HN + (size_t)M * D * 2 <= WS_MB && WS_MB + (size_t)M * D * 2 <= WS_END, "d_ws map");
static_assert(WS_HC + (size_t)M * AB_IN * 2 <= WS_HN && WS_GB + (size_t)M * D * 2 <= WS_HN, "overlay map");

constexpr int LDS_BYTES = 147456;

#define LAS __attribute__((address_space(3)))
typedef unsigned short bf16;
typedef float f32x4 __attribute__((ext_vector_type(4)));
typedef unsigned u32x4 __attribute__((ext_vector_type(4)));
typedef unsigned u32x2 __attribute__((ext_vector_type(2)));
typedef short bf16x8 __attribute__((ext_vector_type(8)));
#define LDS_WAIT() asm volatile("s_waitcnt lgkmcnt(0)" ::: "memory")
__device__ __forceinline__ unsigned f2bf(float f) { unsigned u = __builtin_bit_cast(unsigned, f); return (u + 0x7fffu + ((u >> 16) & 1u)) >> 16; }
__device__ __forceinline__ unsigned pk2(float lo, float hi) { return f2bf(lo) | (f2bf(hi) << 16); }
__device__ __forceinline__ float bflo(unsigned u) { return __uint_as_float(u << 16); }
__device__ __forceinline__ float bfhi(unsigned u) { return __uint_as_float(u & 0xffff0000u); }
__device__ __forceinline__ float wave_sum(float v) {
#pragma unroll
    for (int o = 1; o < 64; o <<= 1) v += __shfl_xor(v, o);
    return v;
}

struct Frame {
    LAS unsigned char* lds;
    int tid, lane, wave, G;
    const float* in[16]; float* out; unsigned char* ws;
};

__device__ __forceinline__ int map_row(int mode, int n0) {
    if (mode == 0) return n0;
    if (mode == 1) return 256 * (n0 >> 7) + (n0 & 127);
    if (mode == 2) return 256 * (n0 >> 7) + 128 + (n0 & 127);
    if (n0 < 1024) return 2048 + n0;
    if (n0 < 2048) { const int j = n0 - 1024; return 256 * (j >> 7) + (j & 127); }
    { const int j = n0 - 2048; return 256 * (j >> 7) + 128 + (j & 127); }
}
__device__ __forceinline__ void p0_transpose_item(const float* W, int K, int N, bf16* WT, int mode, LAS float* scr, int item, int lane) {
    const int nblk = N / 32, kb = item / nblk, nb = item % nblk, k0 = 64 * kb, n0 = 32 * nb; const int drow0 = map_row(mode, n0);
#pragma unroll 8
    for (int i = 0; i < 32; ++i) { const int kk = 2 * i + (lane >> 5); scr[kk * 33 + (lane & 31)] = W[(size_t)(k0 + kk) * N + n0 + (lane & 31)]; }
    LDS_WAIT(); asm volatile("" ::: "memory");
    const int c = lane & 7;
#pragma unroll
    for (int j = 0; j < 4; ++j) { const int n = (lane >> 3) + 8 * j; const LAS float* s = scr + (8 * c) * 33 + n;
        u32x4 o; o.x = pk2(s[0 * 33], s[1 * 33]); o.y = pk2(s[2 * 33], s[3 * 33]); o.z = pk2(s[4 * 33], s[5 * 33]); o.w = pk2(s[6 * 33], s[7 * 33]);
        *(u32x4*)(WT + (size_t)(drow0 + n) * K + k0 + 8 * c) = o; }
    LDS_WAIT(); asm volatile("" ::: "memory");
}

template <int MODE>
__device__ __forceinline__ void norm_phase(const Frame& F, const float* gpost, const float* gpre) {
    const int lane = F.lane, c0 = 8 * lane; const int gw = blockIdx.x * NWAVES + F.wave, NGW = F.G * NWAVES;
    const bf16* MBp = (const bf16*)(F.ws + WS_MB); const float* part = (const float*)(F.ws + WS_PART); bf16* HN = (bf16*)(F.ws + WS_HN);
    f32x4 gp[4], gn[4];
#pragma unroll
    for (int j = 0; j < 4; ++j) { const int c = c0 + (j >> 1) * 512 + (j & 1) * 4;
        gp[j] = (MODE != 0) ? *(const f32x4*)(gpost + c) : (f32x4){0.f, 0.f, 0.f, 0.f};
        gn[j] = (MODE != 3) ? *(const f32x4*)(gpre + c) : (f32x4){0.f, 0.f, 0.f, 0.f}; }
    for (int row = gw; row < M; row += NGW) {
        const float* xr = (MODE <= 1) ? (row < MP ? F.in[0] + (size_t)row * D : F.in[1] + (size_t)(row - MP) * D) : F.out + (size_t)row * D;
        f32x4 x[4];
#pragma unroll
        for (int j = 0; j < 4; ++j) x[j] = *(const f32x4*)(xr + c0 + (j >> 1) * 512 + (j & 1) * 4);
        if (MODE != 0) {
            const bf16* mr = MBp + (size_t)row * D;
            const u32x4 m0 = *(const u32x4*)(mr + c0), m1 = *(const u32x4*)(mr + 512 + c0);
            const float ps = lane < 16 ? part[(size_t)row * 16 + lane] : 0.f;
            const float rstd = 1.0f / sqrtf(wave_sum(ps) * (1.0f / D) + EPS);
            x[0] += (f32x4){bflo(m0.x), bfhi(m0.x), bflo(m0.y), bfhi(m0.y)} * rstd * gp[0];
            x[1] += (f32x4){bflo(m0.z), bfhi(m0.z), bflo(m0.w), bfhi(m0.w)} * rstd * gp[1];
            x[2] += (f32x4){bflo(m1.x), bfhi(m1.x), bflo(m1.y), bfhi(m1.y)} * rstd * gp[2];
            x[3] += (f32x4){bflo(m1.z), bfhi(m1.z), bflo(m1.w), bfhi(m1.w)} * rstd * gp[3];
            float* orow = F.out + (size_t)row * D;
#pragma unroll
            for (int j = 0; j < 4; ++j) *(f32x4*)(orow + c0 + (j >> 1) * 512 + (j & 1) * 4) = x[j];
        }
        if (MODE != 3) {
            float s2 = 0.f;
#pragma unroll
            for (int j = 0; j < 4; ++j) s2 += (x[j][0] * x[j][0] + x[j][1] * x[j][1]) + (x[j][2] * x[j][2] + x[j][3] * x[j][3]);
            const float r2 = 1.0f / sqrtf(wave_sum(s2) * (1.0f / D) + EPS);
            bf16* hr = HN + (size_t)row * D;
#pragma unroll
            for (int h = 0; h < 2; ++h) { const f32x4 a = x[2 * h] * r2 * gn[2 * h], b = x[2 * h + 1] * r2 * gn[2 * h + 1];
                u32x4 o; o.x = pk2(a[0], a[1]); o.y = pk2(a[2], a[3]); o.z = pk2(b[0], b[1]); o.w = pk2(b[2], b[3]);
                *(u32x4*)(hr + c0 + h * 512) = o; }
        }
    }
}

__device__ __forceinline__ void p0_prologue(const Frame& F) {
    LAS float* scr = (LAS float*)(F.lds + F.wave * 16384);
    const int gw = blockIdx.x * NWAVES + F.wave, NGW = F.G * NWAVES;
    constexpr int I_W1 = 16 * 48, I_SQ = 16 * 32, I_GU = 16 * 88, I_DN = 44 * 32, I_CI = 16 * 96;
    constexpr int NITEMS = I_W1 + I_SQ + 2 * (2 * I_GU + I_DN) + I_CI + I_SQ;
    for (int it = gw; it < NITEMS; it += NGW) {
        int r = it; const float* W; int K, N, mode; size_t off;
        if (r < I_W1) { W = F.in[3]; K = D; N = AB_IN; mode = 0; off = WS_W1; }
        else if ((r -= I_W1) < I_SQ) { W = F.in[9]; K = D; N = D; mode = 0; off = WS_WO0; }
        else if ((r -= I_SQ) < I_GU) { W = F.in[13]; K = D; N = FF; mode = 1; off = WS_WGU0; }
        else if ((r -= I_GU) < I_GU) { W = F.in[14]; K = D; N = FF; mode = 2; off = WS_WGU0; }
        else if ((r -= I_GU) < I_DN) { W = F.in[15]; K = FF; N = D; mode = 0; off = WS_WD0; }
        else if ((r -= I_DN) < I_CI) { W = F.in[10]; K = D; N = CIN; mode = 3; off = WS_WCI; }
        else if ((r -= I_CI) < I_SQ) { W = F.in[12]; K = D; N = D; mode = 0; off = WS_WCO; }
        else if ((r -= I_SQ) < I_GU) { W = F.in[13] + (size_t)D * FF; K = D; N = FF; mode = 1; off = WS_WGU1; }
        else if ((r -= I_GU) < I_GU) { W = F.in[14] + (size_t)D * FF; K = D; N = FF; mode = 2; off = WS_WGU1; }
        else { r -= I_GU; W = F.in[15] + (size_t)D * FF; K = FF; N = D; mode = 0; off = WS_WD1; }
        p0_transpose_item(W, K, N, (bf16*)(F.ws + off), mode, scr, r, F.lane);
    }
    bf16* WSB = (bf16*)(F.ws + WS_WSB); bf16* WPT = (bf16*)(F.ws + WS_WPT);
    for (int i = blockIdx.x * NTHR + F.tid; i < 65536; i += F.G * NTHR) {
        WSB[i] = (bf16)f2bf(F.in[5][i]);
        const int g = i >> 14, d = (i >> 7) & 127, c = i & 127;
        WPT[i] = (bf16)f2bf(F.in[7][(g * 128 + c) * 128 + d]);
    }
    norm_phase<0>(F, nullptr, F.in[2]);
}

constexpr int MXS = 272;
__device__ __forceinline__ void mm128(const LAS unsigned char* X, const LAS unsigned char* Y, int w, int fr, int fq, f32x4 (&acc)[8]) {
#pragma unroll
    for (int db = 0; db < 8; ++db) acc[db] = (f32x4){0.f, 0.f, 0.f, 0.f};
#pragma unroll
    for (int ks = 0; ks < 4; ++ks) {
        const bf16x8 yb = *(const LAS bf16x8*)(Y + (16 * w + fr) * MXS + ks * 64 + fq * 16);
#pragma unroll
        for (int db = 0; db < 8; ++db) { const bf16x8 xa = *(const LAS bf16x8*)(X + (db * 16 + fr) * MXS + ks * 64 + fq * 16);
            acc[db] = __builtin_amdgcn_mfma_f32_16x16x32_bf16(xa, yb, acc[db], 0, 0, 0); }
    }
}
__device__ __forceinline__ void mixer_phase(const Frame& F) {
    LAS unsigned char* X = F.lds; LAS unsigned char* Y = F.lds + 128 * MXS; LAS unsigned char* Z = F.lds + 256 * MXS;
    const int tid = F.tid, lane = F.lane, w = F.wave, fr = lane & 15, fq = lane >> 4;
    const bf16* HC = (const bf16*)(F.ws + WS_HC); bf16* AB = (bf16*)(F.ws + WS_HN);
    const bf16* WSB = (const bf16*)(F.ws + WS_WSB); const bf16* WPT = (const bf16*)(F.ws + WS_WPT);
    const float* gv = F.in[4]; const float* bs = F.in[6]; const float* psc = F.in[8];
    for (int idx = blockIdx.x; idx < (M / 128) * 8; idx += F.G) {
        const int chunk = idx >> 3, sub = idx & 7, r0 = chunk * 128;
        if (sub < 4) {
            const int h = sub;
#pragma unroll
            for (int i = 0; i < 4; ++i) { const int pc = tid + i * NTHR, row = pc >> 4, c16 = pc & 15;
                *(LAS u32x4*)(Y + row * MXS + c16 * 16) = *(const u32x4*)(WSB + (h * 128 + row) * 128 + c16 * 8); }
            { const int row = tid >> 2, seg = tid & 3; const bf16* vp = HC + (size_t)(r0 + row) * AB_IN + 512 + h * 128 + seg * 32;
              float v[32];
#pragma unroll
              for (int i = 0; i < 4; ++i) { const u32x4 rw = *(const u32x4*)(vp + 8 * i);
                  v[8 * i + 0] = bflo(rw.x); v[8 * i + 1] = bfhi(rw.x); v[8 * i + 2] = bflo(rw.y); v[8 * i + 3] = bfhi(rw.y);
                  v[8 * i + 4] = bflo(rw.z); v[8 * i + 5] = bfhi(rw.z); v[8 * i + 6] = bflo(rw.w); v[8 * i + 7] = bfhi(rw.w); }
              float s = 0.f;
#pragma unroll
              for (int e = 0; e < 32; ++e) s += v[e];
              s += __shfl_xor(s, 1); s += __shfl_xor(s, 2); const float mu = s * (1.0f / 128.0f);
              float q = 0.f;
#pragma unroll
              for (int e = 0; e < 32; ++e) { v[e] -= mu; q += v[e] * v[e]; }
              q += __shfl_xor(q, 1); q += __shfl_xor(q, 2); const float rstd = 1.0f / sqrtf(q * (1.0f / 128.0f) + EPS);
              const float* gvp = gv + h * 128 + seg * 32;
#pragma unroll
              for (int e4 = 0; e4 < 8; ++e4) { const f32x4 g4 = *(const f32x4*)(gvp + 4 * e4);
#pragma unroll
                  for (int e = 0; e < 4; ++e) { const int d = seg * 32 + 4 * e4 + e;
                      *(LAS unsigned short*)(X + d * MXS + row * 2) = (unsigned short)f2bf(v[4 * e4 + e] * rstd * g4[e]); } }
            }
            __syncthreads();
            f32x4 acc[8]; mm128(X, Y, w, fr, fq, acc);
            const int p = 16 * w + fr; const float bias = bs[h * 128 + p];
            const bf16* up = HC + (size_t)(r0 + p) * AB_IN + h * 128 + fq * 4; bf16* op = AB + (size_t)(r0 + p) * D + h * 128 + fq * 4;
#pragma unroll
            for (int db = 0; db < 8; ++db) { const u32x2 uu = *(const u32x2*)(up + db * 16);
                u32x2 o; o.x = pk2(bflo(uu.x) * (acc[db][0] + bias), bfhi(uu.x) * (acc[db][1] + bias)); o.y = pk2(bflo(uu.y) * (acc[db][2] + bias), bfhi(uu.y) * (acc[db][3] + bias));
                *(u32x2*)(op + db * 16) = o; }
            __syncthreads();
        } else {
            const int gi = sub - 4, hh = 1 << gi; const int pos0 = r0 & (SEQ - 1);
#pragma unroll
            for (int i = 0; i < 4; ++i) { const int pc = tid + i * NTHR, row = pc >> 4, c16 = pc & 15;
                *(LAS u32x4*)(X + row * MXS + c16 * 16) = *(const u32x4*)(WPT + (gi * 128 + row) * 128 + c16 * 8); }
            for (int pc = tid; pc < 144 * 16; pc += NTHR) { const int zr = pc >> 4, c16 = pc & 15, pos = pos0 + zr - 8;
                u32x4 val = (u32x4){0u, 0u, 0u, 0u};
                if (pos >= 0 && pos < SEQ) val = *(const u32x4*)(HC + (size_t)(r0 + zr - 8) * AB_IN + 1024 + gi * 128 + c16 * 8);
                *(LAS u32x4*)(Z + zr * MXS + c16 * 16) = val; }
            __syncthreads();
            { const int i = tid >> 2, seg = tid & 3, pos = pos0 + i;
              const int hi = (pos + hh < SEQ) ? pos + hh : SEQ, lo = (pos - hh > 0) ? pos - hh : 0; const float inv = 1.0f / (float)(hi - lo);
#pragma unroll
              for (int gq = 0; gq < 4; ++gq) { const int cb = (seg * 32 + gq * 8) * 2;
                  float s[8];
#pragma unroll
                  for (int e = 0; e < 8; ++e) s[e] = 0.f;
                  for (int j = -hh; j < hh; ++j) { const u32x4 rw = *(const LAS u32x4*)(Z + (i + 8 + j) * MXS + cb);
                      s[0] += bflo(rw.x); s[1] += bfhi(rw.x); s[2] += bflo(rw.y); s[3] += bfhi(rw.y); s[4] += bflo(rw.z); s[5] += bfhi(rw.z); s[6] += bflo(rw.w); s[7] += bfhi(rw.w); }
                  const u32x4 zc = *(const LAS u32x4*)(Z + (i + 8) * MXS + cb);
                  u32x4 o; o.x = pk2(s[0] * inv - bflo(zc.x), s[1] * inv - bfhi(zc.x)); o.y = pk2(s[2] * inv - bflo(zc.y), s[3] * inv - bfhi(zc.y));
                  o.z = pk2(s[4] * inv - bflo(zc.z), s[5] * inv - bfhi(zc.z)); o.w = pk2(s[6] * inv - bflo(zc.w), s[7] * inv - bfhi(zc.w));
                  *(LAS u32x4*)(Y + i * MXS + cb) = o; }
            }
            __syncthreads();
            f32x4 acc[8]; mm128(X, Y, w, fr, fq, acc);
            const int i = 16 * w + fr; const float* pp = psc + gi * 128 + fq * 4; bf16* op = AB + (size_t)(r0 + i) * D + 512 + gi * 128 + fq * 4;
#pragma unroll
            for (int db = 0; db < 8; ++db) { const f32x4 sc = *(const f32x4*)(pp + db * 16); const f32x4 r = acc[db] * sc;
                u32x2 o; o.x = pk2(r[0], r[1]); o.y = pk2(r[2], r[3]); *(u32x2*)(op + db * 16) = o; }
            __syncthreads();
        }
    }
}

__device__ __forceinline__ void conv_phase(const Frame& F) {
    const bf16* T = (const bf16*)(F.ws + WS_T); const bf16* GB = (const bf16*)(F.ws + WS_GB); bf16* CV = (bf16*)(F.ws + WS_HN);
    const float* cw = F.in[11];
    for (int item = blockIdx.x * NTHR + F.tid; item < M * 128; item += F.G * NTHR) {
        const int row = item >> 7, c8 = (item & 127) * 8, pos = row & (SEQ - 1);
        const size_t o = (size_t)row * D + c8;
        const u32x4 z4 = (u32x4){0u, 0u, 0u, 0u};
        const u32x4 t1 = *(const u32x4*)(T + o), t0 = pos > 0 ? *(const u32x4*)(T + o - D) : z4, t2 = pos < SEQ - 1 ? *(const u32x4*)(T + o + D) : z4, gb = *(const u32x4*)(GB + o);
        const f32x4 w0a = *(const f32x4*)(cw + c8), w0b = *(const f32x4*)(cw + c8 + 4), w1a = *(const f32x4*)(cw + D + c8), w1b = *(const f32x4*)(cw + D + c8 + 4),
                    w2a = *(const f32x4*)(cw + 2 * D + c8), w2b = *(const f32x4*)(cw + 2 * D + c8 + 4);
        const f32x4 a0 = (f32x4){bflo(t0.x), bfhi(t0.x), bflo(t0.y), bfhi(t0.y)}, b0 = (f32x4){bflo(t0.z), bfhi(t0.z), bflo(t0.w), bfhi(t0.w)};
        const f32x4 a1 = (f32x4){bflo(t1.x), bfhi(t1.x), bflo(t1.y), bfhi(t1.y)}, b1 = (f32x4){bflo(t1.z), bfhi(t1.z), bflo(t1.w), bfhi(t1.w)};
        const f32x4 a2 = (f32x4){bflo(t2.x), bfhi(t2.x), bflo(t2.y), bfhi(t2.y)}, b2 = (f32x4){bflo(t2.z), bfhi(t2.z), bflo(t2.w), bfhi(t2.w)};
        const f32x4 ga = (f32x4){bflo(gb.x), bfhi(gb.x), bflo(gb.y), bfhi(gb.y)}, gbb = (f32x4){bflo(gb.z), bfhi(gb.z), bflo(gb.w), bfhi(gb.w)};
        const f32x4 ra = ga * (a0 * w0a + a1 * w1a + a2 * w2a), rb = gbb * (b0 * w0b + b1 * w1b + b2 * w2b);
        u32x4 ov; ov.x = pk2(ra[0], ra[1]); ov.y = pk2(ra[2], ra[3]); ov.z = pk2(rb[0], rb[1]); ov.w = pk2(rb[2], rb[3]);
        *(u32x4*)(CV + o) = ov;
    }
}

struct Args { const float* in[16]; float* out; unsigned char* ws; };
__global__ void __launch_bounds__(NTHR, 2) mk_fwd(Args args) {
    extern __shared__ __attribute__((aligned(16))) unsigned char lds_raw[];
    cg::grid_group grid = cg::this_grid();
    Frame F;
    F.lds = (LAS unsigned char*)lds_raw;
    F.tid = threadIdx.x; F.lane = F.tid & 63; F.wave = __builtin_amdgcn_readfirstlane(F.tid >> 6); F.G = gridDim.x;
#pragma unroll
    for (int i = 0; i < 16; ++i) F.in[i] = args.in[i];
    F.out = args.out; F.ws = args.ws;
    unsigned char* ws = args.ws;
    bf16* HN = (bf16*)(ws + WS_HN); bf16* MB = (bf16*)(ws + WS_MB); bf16* HF = (bf16*)(ws + WS_HF); float* PART = (float*)(ws + WS_PART);
    const float* ng = F.in[2];
    const int bid = (int)blockIdx.x;

    p0_prologue(F);
    grid.sync();
    { pg8::Gemm g{HN, (const bf16*)(ws + WS_W1), M, AB_IN, D}; pg8::StaticOrder S; S.init(M, AB_IN, F.G, bid);
      pg8::EpiAct E{(bf16*)(ws + WS_HC), AB_IN, 4};
      pg8::gemm_phase<pg8::EpiAct, pg8::StaticOrder, true, true>(F.lds, g, S, E); }
    grid.sync();
    mixer_phase(F);
    grid.sync();
    { pg8::Gemm g{HN, (const bf16*)(ws + WS_WO0), M, D, D}; pg8::StaticOrder S; S.init(M, D, F.G, bid);
      pg8::EpiStats E{MB, PART};
      pg8::gemm_phase<pg8::EpiStats, pg8::StaticOrder, true, true>(F.lds, g, S, E); }
    grid.sync();
    norm_phase<1>(F, ng + 1 * D, ng + 2 * D);
    grid.sync();
    { pg8::Gemm g{HN, (const bf16*)(ws + WS_WGU0), M, 2 * FF, D}; pg8::StaticOrder S; S.init(M, 2 * FF, F.G, bid);
      pg8::EpiSwiglu E{HF, FF};
      pg8::gemm_phase<pg8::EpiSwiglu, pg8::StaticOrder, true, true>(F.lds, g, S, E); }
    grid.sync();
    { pg8::Gemm g{HF, (const bf16*)(ws + WS_WD0), M, D, FF}; pg8::StaticOrder S; S.init(M, D, F.G, bid);
      pg8::EpiStats E{MB, PART};
      pg8::gemm_phase<pg8::EpiStats, pg8::StaticOrder, true, true>(F.lds, g, S, E); }
    grid.sync();
    norm_phase<2>(F, ng + 3 * D, ng + 4 * D);
    grid.sync();
    { pg8::Gemm g{HN, (const bf16*)(ws + WS_WCI), M, CIN, D}; pg8::StaticOrder S; S.init(M, CIN, F.G, bid);
      pg8::EpiMulSplit E{(bf16*)(ws + WS_T), (bf16*)(ws + WS_GB)};
      pg8::gemm_phase<pg8::EpiMulSplit, pg8::StaticOrder, true, true>(F.lds, g, S, E); }
    grid.sync();
    conv_phase(F);
    grid.sync();
    { pg8::Gemm g{HN, (const bf16*)(ws + WS_WCO), M, D, D}; pg8::StaticOrder S; S.init(M, D, F.G, bid);
      pg8::EpiStats E{MB, PART};
      pg8::gemm_phase<pg8::EpiStats, pg8::StaticOrder, true, true>(F.lds, g, S, E); }
    grid.sync();
    norm_phase<2>(F, ng + 5 * D, ng + 6 * D);
    grid.sync();
    { pg8::Gemm g{HN, (const bf16*)(ws + WS_WGU1), M, 2 * FF, D}; pg8::StaticOrder S; S.init(M, 2 * FF, F.G, bid);
      pg8::EpiSwiglu E{HF, FF};
      pg8::gemm_phase<pg8::EpiSwiglu, pg8::StaticOrder, true, true>(F.lds, g, S, E); }
    grid.sync();
    { pg8::Gemm g{HF, (const bf16*)(ws + WS_WD1), M, D, FF}; pg8::StaticOrder S; S.init(M, D, F.G, bid);
      pg8::EpiStats E{MB, PART};
      pg8::gemm_phase<pg8::EpiStats, pg8::StaticOrder, true, true>(F.lds, g, S, E); }
    grid.sync();
    norm_phase<3>(F, ng + 7 * D, nullptr);
}

extern "C" void kernel_launch(void* const* d_in, const int* in_sizes, int n_in, void* d_out, int out_size, void* d_ws, size_t ws_size, hipStream_t stream) {
    static int grid = 0;
    if (grid == 0) {
        if (n_in != 16 || out_size != M * D || ws_size < WS_END) { fprintf(stderr, "kernel_launch: unexpected shapes (n_in %d, out %d, ws %zu); nothing launched\n", n_in, out_size, ws_size); grid = -1; return; }
        int dev = 0, cus = 0, per_cu = 0;
        if (hipGetDevice(&dev) != hipSuccess || hipDeviceGetAttribute(&cus, hipDeviceAttributeMultiprocessorCount, dev) != hipSuccess) { grid = -1; return; }
        if (hipFuncSetAttribute((const void*)mk_fwd, hipFuncAttributeMaxDynamicSharedMemorySize, LDS_BYTES) != hipSuccess) { fprintf(stderr, "kernel_launch: hipFuncSetAttribute failed\n"); grid = -1; return; }
        if (hipOccupancyMaxActiveBlocksPerMultiprocessor(&per_cu, (const void*)mk_fwd, NTHR, LDS_BYTES) != hipSuccess || per_cu < 1) { fprintf(stderr, "kernel_launch: occupancy query says %d\n", per_cu); per_cu = 1; }
        (void)hipGetLastError();
        grid = cus;
    }
    if (grid < 0) return;
    Args a{};
    for (int i = 0; i < 16; ++i) a.in[i] = (const float*)d_in[i];
    a.out = (float*)d_out; a.ws = (unsigned char*)d_ws;
    void* kargs[] = {&a};
    hipError_t e = hipLaunchCooperativeKernel((const void*)mk_fwd, dim3(grid), dim3(NTHR), kargs, LDS_BYTES, stream);
    if (e != hipSuccess) fprintf(stderr, "kernel_launch: cooperative launch failed: %s (grid %d)\n", hipGetErrorString(e), grid);
}
```

```cpp
#include <hip/hip_runtime.h>
#include <hip/hip_cooperative_groups.h>
#include <cstdio>
#include <cstdint>
namespace cg = cooperative_groups;

namespace pg8 {
#define PG8_LAS __attribute__((address_space(3)))
typedef unsigned short bf16_t;
typedef short bf16x8 __attribute__((ext_vector_type(8)));
typedef float f32x4 __attribute__((ext_vector_type(4)));
typedef unsigned u32x4 __attribute__((ext_vector_type(4)));
typedef unsigned u32x2 __attribute__((ext_vector_type(2)));
constexpr int BM = 256, BK = 64, HALF = 128, HTB = HALF * BK * 2  , STAGE_BYTES = 8 * HTB, NXCD = 8, WGM = 8;

__host__ __device__ __forceinline__ int lds_byte(int r, int c) { const int st = (r >> 4) * 2 + (c >> 5), rr = r & 15, cc = c & 31, ob = rr * 64 + cc * 2; return st * 1024 + (ob ^ (((ob >> 9) & 1) << 5)); }
__host__ __device__ __forceinline__ void stage_rc(int b, int& R, int& C) { const int st = b / 1024, sb = b % 1024, swz = sb ^ (((sb >> 9) & 1) << 5); R = (st >> 1) * 16 + swz / 64; C = (st & 1) * 32 + (swz % 64) / 2; }
__host__ __device__ __forceinline__ int perm32(int rho) { const int n = rho >> 4, i = rho & 15; return 8 * (i >> 2) + 4 * n + (i & 3); }

struct Unit { int pm, pn; };
struct Gemm { const bf16_t* A; const bf16_t* Bt; int M, N, K; };

struct StaticOrder {
    int nM, nN, nwg, G, c;
    __host__ __device__ void init(int M, int N, int G_, int c_) { nM = M / BM; nN = N / BM; nwg = nM * nN; G = G_; c = c_; }
    __host__ __device__ bool next(int i, Unit& u) const {
        const long L = (long)i * G + c; if (L >= nwg) return false;
        int wgid = (int)L; { const int q = nwg / NXCD, r = nwg % NXCD, xcd = wgid % NXCD, off = wgid / NXCD; wgid = (xcd < r ? xcd * (q + 1) : r * (q + 1) + (xcd - r) * q) + off; }
        const int nig = WGM * nN, gid = wgid / nig, fm = gid * WGM, gsz = (nM - fm) < WGM ? (nM - fm) : WGM;
        u.pm = fm + ((wgid % nig) % gsz); u.pn = (wgid % nig) / gsz; return true;
    }
    __device__ __forceinline__ void a_ready(const Unit&) const {}
    __device__ __forceinline__ void done(const Unit&) const {}
};

__device__ __forceinline__ unsigned cvt_pk_bf16(float lo, float hi) { unsigned r; asm volatile("v_cvt_pk_bf16_f32 %0, %1, %2" : "=v"(r) : "v"(lo), "v"(hi)); return r; }
__device__ __forceinline__ u32x4 pack8(const f32x4 v0, const f32x4 v1) { u32x4 w; w.x = cvt_pk_bf16(v0[0], v0[1]); w.y = cvt_pk_bf16(v0[2], v0[3]); w.z = cvt_pk_bf16(v1[0], v1[1]); w.w = cvt_pk_bf16(v1[2], v1[3]); return w; }
__device__ __forceinline__ float gelu_tanh(float x) { const float t = x * (1.0f + 0.044715f * x * x) * (-2.302208198f); return x * __builtin_amdgcn_rcpf(1.0f + __builtin_amdgcn_exp2f(t)); }
__device__ __forceinline__ float silu_f(float x) { return x * __builtin_amdgcn_rcpf(1.0f + __builtin_amdgcn_exp2f(x * (-1.4426950409f))); }
__device__ __forceinline__ f32x4 gelu4(const f32x4 v) { return (f32x4){gelu_tanh(v[0]), gelu_tanh(v[1]), gelu_tanh(v[2]), gelu_tanh(v[3])}; }
__device__ __forceinline__ f32x4 silu4(const f32x4 v) { return (f32x4){silu_f(v[0]), silu_f(v[1]), silu_f(v[2]), silu_f(v[3])}; }

struct EpiAct {
    static constexpr bool PERM = true, AFTER_DRAIN = false;
    bf16_t* O; int ldc; int n_act;
    __device__ __forceinline__ void operator()(const f32x4 (&acc)[2][2][4][2], const Unit& u, int wr, int wc, int fr, int fq) const {
        const int row0 = u.pm * BM + wr * 64 + fr, col0 = u.pn * BM + wc * 32 + 8 * fq; const bool act = u.pn < n_act;
#pragma unroll
        for (int ai = 0; ai < 2; ++ai)
#pragma unroll
            for (int m = 0; m < 4; ++m) { bf16_t* rowp = O + (size_t)(row0 + ai * HALF + m * 16) * ldc + col0;
#pragma unroll
                for (int bj = 0; bj < 2; ++bj) { f32x4 v0 = acc[ai][bj][m][0], v1 = acc[ai][bj][m][1];
                    if (act) { v0 = gelu4(v0); v1 = gelu4(v1); }
                    *(u32x4*)(rowp + bj * HALF) = pack8(v0, v1); } }
    }
};
struct EpiStats {
    static constexpr bool PERM = true, AFTER_DRAIN = false;
    bf16_t* O; float* part;
    __device__ __forceinline__ void operator()(const f32x4 (&acc)[2][2][4][2], const Unit& u, int wr, int wc, int fr, int fq) const {
        const int row0 = u.pm * BM + wr * 64 + fr, col0 = u.pn * BM + wc * 32 + 8 * fq;
#pragma unroll
        for (int ai = 0; ai < 2; ++ai)
#pragma unroll
            for (int m = 0; m < 4; ++m) { const int row = row0 + ai * HALF + m * 16; bf16_t* rowp = O + (size_t)row * 1024 + col0; float s = 0.f;
#pragma unroll
                for (int bj = 0; bj < 2; ++bj) { const f32x4 v0 = acc[ai][bj][m][0], v1 = acc[ai][bj][m][1];
                    s += (v0[0] * v0[0] + v0[1] * v0[1]) + (v0[2] * v0[2] + v0[3] * v0[3]) + (v1[0] * v1[0] + v1[1] * v1[1]) + (v1[2] * v1[2] + v1[3] * v1[3]);
                    *(u32x4*)(rowp + bj * HALF) = pack8(v0, v1); }
                s += __shfl_xor(s, 16); s += __shfl_xor(s, 32);
                if (fq == 0) part[(size_t)row * 16 + u.pn * 4 + wc] = s; }
    }
};
struct EpiSwiglu {
    static constexpr bool PERM = true, AFTER_DRAIN = false;
    bf16_t* O; int ldc;
    __device__ __forceinline__ void operator()(const f32x4 (&acc)[2][2][4][2], const Unit& u, int wr, int wc, int fr, int fq) const {
        const int row0 = u.pm * BM + wr * 64 + fr, col0 = u.pn * HALF + wc * 32 + 8 * fq;
#pragma unroll
        for (int ai = 0; ai < 2; ++ai)
#pragma unroll
            for (int m = 0; m < 4; ++m) { bf16_t* rowp = O + (size_t)(row0 + ai * HALF + m * 16) * ldc + col0;
                const f32x4 v0 = silu4(acc[ai][0][m][0]) * acc[ai][1][m][0], v1 = silu4(acc[ai][0][m][1]) * acc[ai][1][m][1];
                *(u32x4*)rowp = pack8(v0, v1); }
    }
};
struct EpiMulSplit {
    static constexpr bool PERM = true, AFTER_DRAIN = false;
    bf16_t* T; bf16_t* GB;
    __device__ __forceinline__ void operator()(const f32x4 (&acc)[2][2][4][2], const Unit& u, int wr, int wc, int fr, int fq) const {
        const int row0 = u.pm * BM + wr * 64 + fr;
        if (u.pn < 8) { const int col0 = u.pn * HALF + wc * 32 + 8 * fq;
#pragma unroll
            for (int ai = 0; ai < 2; ++ai)
#pragma unroll
                for (int m = 0; m < 4; ++m) { bf16_t* rowp = T + (size_t)(row0 + ai * HALF + m * 16) * 1024 + col0;
                    *(u32x4*)rowp = pack8(acc[ai][0][m][0] * acc[ai][1][m][0], acc[ai][0][m][1] * acc[ai][1][m][1]); }
        } else { const int col0 = (u.pn - 8) * BM + wc * 32 + 8 * fq;
#pragma unroll
            for (int ai = 0; ai < 2; ++ai)
#pragma unroll
                for (int m = 0; m < 4; ++m) { bf16_t* rowp = GB + (size_t)(row0 + ai * HALF + m * 16) * 1024 + col0;
#pragma unroll
                    for (int bj = 0; bj < 2; ++bj) *(u32x4*)(rowp + bj * HALF) = pack8(acc[ai][bj][m][0], acc[ai][bj][m][1]); }
        }
    }
};

template <class Epi, class Sched, bool ALIGN_EPI = false, bool SP2 = false>
__device__ __forceinline__ void gemm_phase(PG8_LAS unsigned char* lds, const Gemm g, const Sched& S, const Epi& E) {
    const int tid = threadIdx.x, wid = __builtin_amdgcn_readfirstlane(tid >> 6), lane = tid & 63, wr = wid >> 2, wc = wid & 3, fr = lane & 15, fq = lane >> 4;
    const int K = g.K, nt = K / BK;
    unsigned voffA[2], voffB[2];
#pragma unroll
    for (int i = 0; i < 2; ++i) { int R, C; stage_rc(tid * 16 + i * 8192, R, C); const int Rb = Epi::PERM ? ((R & ~31) + perm32(R & 31)) : R;
        voffA[i] = (unsigned)(R * K + C) * 2u; voffB[i] = (unsigned)(Rb * K + C) * 2u; }
    const size_t kstep = (size_t)(BK * 2);
    const size_t hstep = (size_t)HALF * K * 2;
    const size_t tstep = 2 * hstep;
    const unsigned ldsw = (unsigned)wid * 1024u;
    const int aoff = lds_byte(wr * 64 + fr, fq * 8), boff = lds_byte(wc * 32 + fr, fq * 8);
#define PG8_SA(b, h) (((b) * 2 + (h)) * HTB)
#define PG8_SB(b, h) ((4 + (b) * 2 + (h)) * HTB)
#define PG8_STAGE(bufoff, gbase, voff) do { _Pragma("unroll") for (int _i = 0; _i < 2; ++_i) \
        __builtin_amdgcn_global_load_lds((const unsigned*)((const char*)(gbase) + (voff)[_i]), (PG8_LAS unsigned*)(lds + (bufoff) + ldsw + _i * 8192), 16, 0, 0); } while (0)
#define PG8_LDA(dst, b, h) do { _Pragma("unroll") for (int m = 0; m < 4; ++m) _Pragma("unroll") for (int k = 0; k < 2; ++k) dst[m][k] = *(const PG8_LAS bf16x8*)(lds + PG8_SA(b, h) + aoff + m * 2048 + k * 1024); } while (0)
#define PG8_LDB(dst, b, h) do { _Pragma("unroll") for (int n = 0; n < 2; ++n) _Pragma("unroll") for (int k = 0; k < 2; ++k) dst[n][k] = *(const PG8_LAS bf16x8*)(lds + PG8_SB(b, h) + boff + n * 2048 + k * 1024); } while (0)
#define PG8_MMA(ai, bj, At, Bt) do { __builtin_amdgcn_s_setprio(1); _Pragma("unroll") for (int m = 0; m < 4; ++m) _Pragma("unroll") for (int n = 0; n < 2; ++n) _Pragma("unroll") for (int k = 0; k < 2; ++k) \
        acc[ai][bj][m][n] = __builtin_amdgcn_mfma_f32_16x16x32_bf16(Bt[n][k], At[m][k], acc[ai][bj][m][n], 0, 0, 0); __builtin_amdgcn_s_setprio(0); } while (0)
#define PG8_WAIT_V(n) asm volatile("s_waitcnt vmcnt(" #n ")" ::: "memory")
#define PG8_WAIT_L(n) asm volatile("s_waitcnt lgkmcnt(" #n ")" ::: "memory")
#define PG8_BAR __builtin_amdgcn_s_barrier()
#define PG8_SCHED __builtin_amdgcn_sched_barrier(0)
    Unit cur, nxt; int ui = 0;
    if (!S.next(0, cur)) return;
    f32x4 acc[2][2][4][2];
#pragma unroll
    for (int a = 0; a < 2; ++a)
#pragma unroll
        for (int b = 0; b < 2; ++b)
#pragma unroll
            for (int m = 0; m < 4; ++m)
#pragma unroll
                for (int n = 0; n < 2; ++n) acc[a][b][m][n] = (f32x4){0.f, 0.f, 0.f, 0.f};
    bf16x8 At[4][2], B0[2][2], B1[2][2];
    const char* cA = (const char*)g.A + (size_t)cur.pm * tstep; const char* cB = (const char*)g.Bt + (size_t)cur.pn * tstep;
    S.a_ready(cur);
    if constexpr (SP2) {
        PG8_STAGE(PG8_SB(0, 0), cB, voffB); PG8_STAGE(PG8_SB(0, 1), cB + hstep, voffB); PG8_STAGE(PG8_SA(0, 0), cA, voffA); PG8_STAGE(PG8_SA(0, 1), cA + hstep, voffA);
        if (wr == 1) PG8_BAR;
        PG8_WAIT_V(2); PG8_BAR;
        PG8_STAGE(PG8_SB(1, 0), cB + kstep, voffB); PG8_STAGE(PG8_SA(1, 0), cA + kstep, voffA); PG8_STAGE(PG8_SB(1, 1), cB + hstep + kstep, voffB);
        PG8_WAIT_V(6); PG8_BAR;
    } else {
        PG8_STAGE(PG8_SB(0, 0), cB, voffB); PG8_STAGE(PG8_SA(0, 0), cA, voffA); PG8_STAGE(PG8_SB(0, 1), cB + hstep, voffB); PG8_STAGE(PG8_SA(0, 1), cA + hstep, voffA);
        if (wr == 1) PG8_BAR;
        PG8_WAIT_V(4); PG8_BAR;
        PG8_STAGE(PG8_SB(1, 0), cB + kstep, voffB); PG8_STAGE(PG8_SA(1, 0), cA + kstep, voffA); PG8_STAGE(PG8_SB(1, 1), cB + hstep + kstep, voffB);
        PG8_WAIT_V(6); PG8_BAR;
    }
    for (;;) {
        const bool has_next = S.next(ui + 1, nxt);
        const char* nA = has_next ? (const char*)g.A + (size_t)nxt.pm * tstep : cA; const char* nB = has_next ? (const char*)g.Bt + (size_t)nxt.pn * tstep : cB;
        for (int t = 0; t < nt; t += 2) {
            const bool last = (t == nt - 2);
            const char* a1 = cA + (size_t)(t + 1) * kstep;
            const char* a2 = last ? nA : cA + (size_t)(t + 2) * kstep; const char* b2 = last ? nB : cB + (size_t)(t + 2) * kstep;
            const char* a3 = a2 + kstep; const char* b3 = b2 + kstep;
            if (last && has_next) S.a_ready(nxt);
            if constexpr (SP2) {
            PG8_LDB(B0, 0, 0); PG8_LDB(B1, 0, 1); PG8_SCHED; PG8_LDA(At, 0, 0); PG8_STAGE(PG8_SA(1, 1), a1 + hstep, voffA);
            PG8_WAIT_V(8); PG8_WAIT_L(0); PG8_BAR; PG8_MMA(0, 0, At, B0); PG8_MMA(0, 1, At, B1); PG8_BAR; PG8_SCHED;
            PG8_LDA(At, 0, 1); PG8_STAGE(PG8_SB(0, 0), b2, voffB); PG8_STAGE(PG8_SB(0, 1), b2 + hstep, voffB); PG8_STAGE(PG8_SA(0, 0), a2, voffA);
            PG8_WAIT_V(8); PG8_WAIT_L(0); PG8_BAR; PG8_MMA(1, 0, At, B0); PG8_MMA(1, 1, At, B1); PG8_BAR; PG8_SCHED;
            PG8_LDB(B0, 1, 0); PG8_LDB(B1, 1, 1); PG8_SCHED; PG8_LDA(At, 1, 0); PG8_STAGE(PG8_SA(0, 1), a2 + hstep, voffA);
            PG8_WAIT_V(8); PG8_WAIT_L(0); PG8_BAR; PG8_MMA(0, 0, At, B0); PG8_MMA(0, 1, At, B1); PG8_BAR; PG8_SCHED;
            PG8_LDA(At, 1, 1); PG8_STAGE(PG8_SB(1, 0), b3, voffB); PG8_STAGE(PG8_SB(1, 1), b3 + hstep, voffB); PG8_STAGE(PG8_SA(1, 0), a3, voffA);
            PG8_WAIT_V(8); PG8_WAIT_L(0); PG8_BAR; PG8_MMA(1, 0, At, B0); PG8_MMA(1, 1, At, B1); PG8_BAR; PG8_SCHED;
            } else {
            PG8_LDB(B0, 0, 0); PG8_SCHED; PG8_LDA(At, 0, 0); PG8_STAGE(PG8_SA(1, 1), a1 + hstep, voffA);
            PG8_WAIT_L(8); PG8_BAR; PG8_WAIT_L(0); PG8_MMA(0, 0, At, B0); PG8_BAR; PG8_SCHED;
            PG8_LDB(B1, 0, 1); PG8_STAGE(PG8_SB(0, 0), b2, voffB);
            PG8_BAR; PG8_WAIT_L(0); PG8_MMA(0, 1, At, B1); PG8_BAR;
            PG8_LDA(At, 0, 1); PG8_STAGE(PG8_SA(0, 0), a2, voffA);
            PG8_BAR; PG8_WAIT_L(0); PG8_MMA(1, 0, At, B0); PG8_BAR; PG8_SCHED;
            PG8_STAGE(PG8_SB(0, 1), b2 + hstep, voffB);
            PG8_WAIT_V(6); PG8_BAR; PG8_MMA(1, 1, At, B1); PG8_BAR;
            PG8_LDB(B0, 1, 0); PG8_SCHED; PG8_LDA(At, 1, 0); PG8_STAGE(PG8_SA(0, 1), a2 + hstep, voffA);
            PG8_WAIT_L(8); PG8_BAR; PG8_WAIT_L(0); PG8_MMA(0, 0, At, B0); PG8_BAR; PG8_SCHED;
            PG8_LDB(B1, 1, 1); PG8_STAGE(PG8_SB(1, 0), b3, voffB);
            PG8_BAR; PG8_WAIT_L(0); PG8_MMA(0, 1, At, B1); PG8_BAR;
            PG8_LDA(At, 1, 1); PG8_STAGE(PG8_SA(1, 0), a3, voffA);
            PG8_BAR; PG8_WAIT_L(0); PG8_MMA(1, 0, At, B0); PG8_BAR; PG8_SCHED;
            PG8_STAGE(PG8_SB(1, 1), b3 + hstep, voffB);
            PG8_WAIT_V(6); PG8_BAR; PG8_MMA(1, 1, At, B1); PG8_BAR;
            }
        }
        if constexpr (ALIGN_EPI) { if (wr == 0) PG8_BAR; }
        if constexpr (!Epi::AFTER_DRAIN) { E(acc, cur, wr, wc, fr, fq); S.done(cur); }
        if (!has_next) break;
#pragma unroll
        for (int a = 0; a < 2; ++a)
#pragma unroll
            for (int b = 0; b < 2; ++b)
#pragma unroll
                for (int m = 0; m < 4; ++m)
#pragma unroll
                    for (int n = 0; n < 2; ++n) acc[a][b][m][n] = (f32x4){0.f, 0.f, 0.f, 0.f};
        cur = nxt; cA = nA; cB = nB; ++ui;
        if constexpr (ALIGN_EPI) { if (wr == 1) PG8_BAR; }
    }
    PG8_WAIT_V(0);
    if constexpr (!ALIGN_EPI) { if (wr == 0) PG8_BAR; }
    PG8_BAR;
#undef PG8_SA
#undef PG8_SB
#undef PG8_STAGE
#undef PG8_LDA
#undef PG8_LDB
#undef PG8_MMA
#undef PG8_WAIT_V
#undef PG8_WAIT_L
#undef PG8_BAR
#undef PG8_SCHED
}
}

constexpr int D = 1024, SEQ = 4096, MP = 8 * SEQ, MS = 4 * SEQ, M = MP + MS;
constexpr int AB_IN = 1536, FF = 2816, CIN = 3072;
constexpr float EPS = 1e-6f;
constexpr int NWAVES = 8, NTHR = 512;

constexpr size_t MiB = 1u << 20;
constexpr size_t WS_WSB = 1 * MiB, WS_WPT = 1 * MiB + 128 * 1024;
constexpr size_t WS_W1 = 2 * MiB, WS_WO0 = 5 * MiB, WS_WGU0 = 7 * MiB, WS_WD0 = 18 * MiB, WS_WCI = 24 * MiB, WS_WCO = 30 * MiB, WS_WGU1 = 32 * MiB, WS_WD1 = 43 * MiB;
constexpr size_t WS_PART = 49 * MiB;
constexpr size_t WS_HF = 52 * MiB;
constexpr size_t WS_HC = WS_HF, WS_T = WS_HF, WS_GB = WS_HF + 96 * MiB;
constexpr size_t WS_HN = 316 * MiB;
constexpr size_t WS_MB = 412 * MiB;
constexpr size_t WS_END = 508 * MiB;
static_assert(WS_WD1 + (size_t)D * FF * 2 <= WS_PART && WS_PART + (size_t)M * 64 <= WS_HF && WS_HF + (size_t)M * FF * 2 <= WS_HN && WS_HN + (size_t)M * D * 2 <= WS_MB && WS_MB + (size_t)M * D * 2 <= WS_END, "d_ws map");
static_assert(WS_HC + (size_t)M * AB_IN * 2 <= WS_HN && WS_GB + (size_t)M * D * 2 <= WS_HN, "overlay map");

constexpr int LDS_BYTES = 147456;

#define LAS __attribute__((address_space(3)))
typedef unsigned short bf16;
typedef float f32x4 __attribute__((ext_vector_type(4)));
typedef unsigned u32x4 __attribute__((ext_vector_type(4)));
typedef unsigned u32x2 __attribute__((ext_vector_type(2)));
typedef short bf16x8 __attribute__((ext_vector_type(8)));
#define LDS_WAIT() asm volatile("s_waitcnt lgkmcnt(0)" ::: "memory")
__device__ __forceinline__ unsigned f2bf(float f) { unsigned u = __builtin_bit_cast(unsigned, f); return (u + 0x7fffu + ((u >> 16) & 1u)) >> 16; }
__device__ __forceinline__ unsigned pk2(float lo, float hi) { return f2bf(lo) | (f2bf(hi) << 16); }
__device__ __forceinline__ float bflo(unsigned u) { return __uint_as_float(u << 16); }
__device__ __forceinline__ float bfhi(unsigned u) { return __uint_as_float(u & 0xffff0000u); }
__device__ __forceinline__ float wave_sum(float v) {
#pragma unroll
    for (int o = 1; o < 64; o <<= 1) v += __shfl_xor(v, o);
    return v;
}


#define XB_TMO      128
#define XB_XCNT(j)  (256  + 64 * (j))
#define XB_XSUB(j)  (1280 + 64 * (j))
#define XB_XGEN(j)  (2304 + 64 * (j))
#define XB_TOP      3328
#define XB_TOPGEN   3392
#define XCD_BAR_WORDS 3456
#define XB_SPIN_CAP (1u << 18)
__device__ __forceinline__ unsigned xb_ld(unsigned* p)              { return __hip_atomic_load(p, __ATOMIC_RELAXED, __HIP_MEMORY_SCOPE_AGENT); }
__device__ __forceinline__ unsigned xb_add(unsigned* p, unsigned v) { return __hip_atomic_fetch_add(p, v, __ATOMIC_RELAXED, __HIP_MEMORY_SCOPE_AGENT); }
__device__ __forceinline__ unsigned xb_xcc_id() { return (unsigned)__builtin_amdgcn_s_getreg((3 << 11) | 20) & 0xFu; }
#define XB_SPIN(cond, bar) do { unsigned _sp = 0; while (cond) { __builtin_amdgcn_s_sleep(1); \
    if ((++_sp & 255u) == 0u) { if (xb_ld(&(bar)[XB_TMO])) break; if (_sp > XB_SPIN_CAP) { atomicAdd(&(bar)[XB_TMO], 1u); break; } } } } while (0)
struct XcdBarrier { unsigned* bar; unsigned x; volatile LAS unsigned* st; };
__device__ __forceinline__ XcdBarrier xcd_barrier_post(unsigned* bar, volatile LAS unsigned* st) {
    XcdBarrier b; b.bar = bar; b.x = xb_xcc_id(); b.st = st;
    if (threadIdx.x == 0) (void)xb_add(&bar[XB_XCNT(b.x)], 1u);
    return b;
}
__device__ __forceinline__ void xcd_barrier_complete(unsigned* bar, unsigned x, unsigned& nloc, unsigned& nx) {
    const unsigned G = gridDim.x * gridDim.y * gridDim.z;
    unsigned sum, cnt, mine, sp = 0u;
    for (;;) {
        sum = 0u; cnt = 0u; mine = 0u;
#pragma unroll
        for (unsigned j = 0; j < 16; ++j) { const unsigned c = xb_ld(&bar[XB_XCNT(j)]); sum += c; cnt += (c > 0u) ? 1u : 0u; mine = (j == x) ? c : mine; }
        if (sum == G) break;
        __builtin_amdgcn_s_sleep(1);
        if ((++sp & 255u) == 0u) { if (xb_ld(&bar[XB_TMO])) break; if (sp > XB_SPIN_CAP) { atomicAdd(&bar[XB_TMO], 1u); break; } }
    }
    nloc = mine > 0u ? mine : 1u; nx = cnt > 0u ? cnt : 1u;
}
__device__ __forceinline__ void xcd_barrier(const XcdBarrier& b) {
    asm volatile("s_waitcnt vmcnt(0)" ::: "memory");
    __syncthreads();
    if (threadIdx.x == 0) {
        unsigned* bar = b.bar;
        __builtin_amdgcn_s_waitcnt(0);
        unsigned nloc = b.st[0], nx = b.st[1];
        if (nloc == 0u) { xcd_barrier_complete(bar, b.x, nloc, nx); b.st[0] = nloc; b.st[1] = nx; }
        const unsigned old = xb_add(&bar[XB_XSUB(b.x)], 1u);
        const unsigned gen = old / nloc;
        if (old + 1u == (gen + 1u) * nloc) {
            __builtin_amdgcn_fence(__ATOMIC_RELEASE, "agent");
            asm volatile("s_waitcnt vmcnt(0)" ::: "memory");
            const unsigned og = xb_add(&bar[XB_TOP], 1u);
            const unsigned tg = og / nx;
            if (og + 1u == (tg + 1u) * nx) xb_add(&bar[XB_TOPGEN], 1u);
            else XB_SPIN(xb_ld(&bar[XB_TOPGEN]) == tg, bar);
            __builtin_amdgcn_fence(__ATOMIC_ACQUIRE, "agent");
            xb_add(&bar[XB_XGEN(b.x)], 1u);
            asm volatile("s_waitcnt vmcnt(0)" ::: "memory");
        } else {
            XB_SPIN(xb_ld(&bar[XB_XGEN(b.x)]) == gen, bar);
            __builtin_amdgcn_fence(__ATOMIC_ACQUIRE, "agent");
            asm volatile("s_waitcnt vmcnt(0)" ::: "memory");
        }
    }
    __syncthreads();
}

struct Frame {
    LAS unsigned char* lds;
    int tid, lane, wave, G;
    const float* in[16]; float* out; unsigned char* ws;
};

__device__ __forceinline__ int map_row(int mode, int n0) {
    if (mode == 0) return n0;
    if (mode == 1) return 256 * (n0 >> 7) + (n0 & 127);
    if (mode == 2) return 256 * (n0 >> 7) + 128 + (n0 & 127);
    if (n0 < 1024) return 2048 + n0;
    if (n0 < 2048) { const int j = n0 - 1024; return 256 * (j >> 7) + (j & 127); }
    { const int j = n0 - 2048; return 256 * (j >> 7) + 128 + (j & 127); }
}
__device__ __forceinline__ void p0_transpose_item(const float* W, int K, int N, bf16* WT, int mode, LAS float* scr, int item, int lane) {
    const int nblk = N / 32, kb = item / nblk, nb = item % nblk, k0 = 64 * kb, n0 = 32 * nb; const int drow0 = map_row(mode, n0);
#pragma unroll 8
    for (int i = 0; i < 32; ++i) { const int kk = 2 * i + (lane >> 5); scr[kk * 33 + (lane & 31)] = W[(size_t)(k0 + kk) * N + n0 + (lane & 31)]; }
    LDS_WAIT(); asm volatile("" ::: "memory");
    const int c = lane & 7;
#pragma unroll
    for (int j = 0; j < 4; ++j) { const int n = (lane >> 3) + 8 * j; const LAS float* s = scr + (8 * c) * 33 + n;
        u32x4 o; o.x = pk2(s[0 * 33], s[1 * 33]); o.y = pk2(s[2 * 33], s[3 * 33]); o.z = pk2(s[4 * 33], s[5 * 33]); o.w = pk2(s[6 * 33], s[7 * 33]);
        *(u32x4*)(WT + (size_t)(drow0 + n) * K + k0 + 8 * c) = o; }
    LDS_WAIT(); asm volatile("" ::: "memory");
}

template <int MODE>
__device__ __forceinline__ void norm_phase(const Frame& F, const float* gpost, const float* gpre) {
    const int lane = F.lane, c0 = 8 * lane; const int gw = blockIdx.x * NWAVES + F.wave, NGW = F.G * NWAVES;
    const bf16* MBp = (const bf16*)(F.ws + WS_MB); const float* part = (const float*)(F.ws + WS_PART); bf16* HN = (bf16*)(F.ws + WS_HN);
    f32x4 gp[4], gn[4];
#pragma unroll
    for (int j = 0; j < 4; ++j) { const int c = c0 + (j >> 1) * 512 + (j & 1) * 4;
        gp[j] = (MODE != 0) ? *(const f32x4*)(gpost + c) : (f32x4){0.f, 0.f, 0.f, 0.f};
        gn[j] = (MODE != 3) ? *(const f32x4*)(gpre + c) : (f32x4){0.f, 0.f, 0.f, 0.f}; }
    for (int row = gw; row < M; row += NGW) {
        const float* xr = (MODE <= 1) ? (row < MP ? F.in[0] + (size_t)row * D : F.in[1] + (size_t)(row - MP) * D) : F.out + (size_t)row * D;
        f32x4 x[4];
#pragma unroll
        for (int j = 0; j < 4; ++j) x[j] = *(const f32x4*)(xr + c0 + (j >> 1) * 512 + (j & 1) * 4);
        if (MODE != 0) {
            const bf16* mr = MBp + (size_t)row * D;
            const u32x4 m0 = *(const u32x4*)(mr + c0), m1 = *(const u32x4*)(mr + 512 + c0);
            const float ps = lane < 16 ? part[(size_t)row * 16 + lane] : 0.f;
            const float rstd = 1.0f / sqrtf(wave_sum(ps) * (1.0f / D) + EPS);
            x[0] += (f32x4){bflo(m0.x), bfhi(m0.x), bflo(m0.y), bfhi(m0.y)} * rstd * gp[0];
            x[1] += (f32x4){bflo(m0.z), bfhi(m0.z), bflo(m0.w), bfhi(m0.w)} * rstd * gp[1];
            x[2] += (f32x4){bflo(m1.x), bfhi(m1.x), bflo(m1.y), bfhi(m1.y)} * rstd * gp[2];
            x[3] += (f32x4){bflo(m1.z), bfhi(m1.z), bflo(m1.w), bfhi(m1.w)} * rstd * gp[3];
            float* orow = F.out + (size_t)row * D;
#pragma unroll
            for (int j = 0; j < 4; ++j) *(f32x4*)(orow + c0 + (j >> 1) * 512 + (j & 1) * 4) = x[j];
        }
        if (MODE != 3) {
            float s2 = 0.f;
#pragma unroll
            for (int j = 0; j < 4; ++j) s2 += (x[j][0] * x[j][0] + x[j][1] * x[j][1]) + (x[j][2] * x[j][2] + x[j][3] * x[j][3]);
            const float r2 = 1.0f / sqrtf(wave_sum(s2) * (1.0f / D) + EPS);
            bf16* hr = HN + (size_t)row * D;
#pragma unroll
            for (int h = 0; h < 2; ++h) { const f32x4 a = x[2 * h] * r2 * gn[2 * h], b = x[2 * h + 1] * r2 * gn[2 * h + 1];
                u32x4 o; o.x = pk2(a[0], a[1]); o.y = pk2(a[2], a[3]); o.z = pk2(b[0], b[1]); o.w = pk2(b[2], b[3]);
                *(u32x4*)(hr + c0 + h * 512) = o; }
        }
    }
}

__device__ __forceinline__ void p0_prologue(const Frame& F) {
    LAS float* scr = (LAS float*)(F.lds + F.wave * 16384);
    const int gw = blockIdx.x * NWAVES + F.wave, NGW = F.G * NWAVES;
    constexpr int I_W1 = 16 * 48, I_SQ = 16 * 32, I_GU = 16 * 88, I_DN = 44 * 32, I_CI = 16 * 96;
    constexpr int NITEMS = I_W1 + I_SQ + 2 * (2 * I_GU + I_DN) + I_CI + I_SQ;
    for (int it = gw; it < NITEMS; it += NGW) {
        int r = it; const float* W; int K, N, mode; size_t off;
        if (r < I_W1) { W = F.in[3]; K = D; N = AB_IN; mode = 0; off = WS_W1; }
        else if ((r -= I_W1) < I_SQ) { W = F.in[9]; K = D; N = D; mode = 0; off = WS_WO0; }
        else if ((r -= I_SQ) < I_GU) { W = F.in[13]; K = D; N = FF; mode = 1; off = WS_WGU0; }
        else if ((r -= I_GU) < I_GU) { W = F.in[14]; K = D; N = FF; mode = 2; off = WS_WGU0; }
        else if ((r -= I_GU) < I_DN) { W = F.in[15]; K = FF; N = D; mode = 0; off = WS_WD0; }
        else if ((r -= I_DN) < I_CI) { W = F.in[10]; K = D; N = CIN; mode = 3; off = WS_WCI; }
        else if ((r -= I_CI) < I_SQ) { W = F.in[12]; K = D; N = D; mode = 0; off = WS_WCO; }
        else if ((r -= I_SQ) < I_GU) { W = F.in[13] + (size_t)D * FF; K = D; N = FF; mode = 1; off = WS_WGU1; }
        else if ((r -= I_GU) < I_GU) { W = F.in[14] + (size_t)D * FF; K = D; N = FF; mode = 2; off = WS_WGU1; }
        else { r -= I_GU; W = F.in[15] + (size_t)D * FF; K = FF; N = D; mode = 0; off = WS_WD1; }
        p0_transpose_item(W, K, N, (bf16*)(F.ws + off), mode, scr, r, F.lane);
    }
    bf16* WSB = (bf16*)(F.ws + WS_WSB); bf16* WPT = (bf16*)(F.ws + WS_WPT);
    for (int i = blockIdx.x * NTHR + F.tid; i < 65536; i += F.G * NTHR) {
        WSB[i] = (bf16)f2bf(F.in[5][i]);
        const int g = i >> 14, d = (i >> 7) & 127, c = i & 127;
        WPT[i] = (bf16)f2bf(F.in[7][(g * 128 + c) * 128 + d]);
    }
    norm_phase<0>(F, nullptr, F.in[2]);
}

constexpr int MXS = 272;
__device__ __forceinline__ void mm128(const LAS unsigned char* X, const LAS unsigned char* Y, int w, int fr, int fq, f32x4 (&acc)[8]) {
#pragma unroll
    for (int db = 0; db < 8; ++db) acc[db] = (f32x4){0.f, 0.f, 0.f, 0.f};
#pragma unroll
    for (int ks = 0; ks < 4; ++ks) {
        const bf16x8 yb = *(const LAS bf16x8*)(Y + (16 * w + fr) * MXS + ks * 64 + fq * 16);
#pragma unroll
        for (int db = 0; db < 8; ++db) { const bf16x8 xa = *(const LAS bf16x8*)(X + (db * 16 + fr) * MXS + ks * 64 + fq * 16);
            acc[db] = __builtin_amdgcn_mfma_f32_16x16x32_bf16(xa, yb, acc[db], 0, 0, 0); }
    }
}
__device__ __forceinline__ void mixer_phase(const Frame& F) {
    LAS unsigned char* X = F.lds; LAS unsigned char* Y = F.lds + 128 * MXS; LAS unsigned char* Z = F.lds + 256 * MXS;
    const int tid = F.tid, lane = F.lane, w = F.wave, fr = lane & 15, fq = lane >> 4;
    const bf16* HC = (const bf16*)(F.ws + WS_HC); bf16* AB = (bf16*)(F.ws + WS_HN);
    const bf16* WSB = (const bf16*)(F.ws + WS_WSB); const bf16* WPT = (const bf16*)(F.ws + WS_WPT);
    const float* gv = F.in[4]; const float* bs = F.in[6]; const float* psc = F.in[8];
    for (int idx = blockIdx.x; idx < (M / 128) * 8; idx += F.G) {
        const int chunk = idx >> 3, sub = idx & 7, r0 = chunk * 128;
        if (sub < 4) {
            const int h = sub;
#pragma unroll
            for (int i = 0; i < 4; ++i) { const int pc = tid + i * NTHR, row = pc >> 4, c16 = pc & 15;
                *(LAS u32x4*)(Y + row * MXS + c16 * 16) = *(const u32x4*)(WSB + (h * 128 + row) * 128 + c16 * 8); }
            { const int row = tid >> 2, seg = tid & 3; const bf16* vp = HC + (size_t)(r0 + row) * AB_IN + 512 + h * 128 + seg * 32;
              float v[32];
#pragma unroll
              for (int i = 0; i < 4; ++i) { const u32x4 rw = *(const u32x4*)(vp + 8 * i);
                  v[8 * i + 0] = bflo(rw.x); v[8 * i + 1] = bfhi(rw.x); v[8 * i + 2] = bflo(rw.y); v[8 * i + 3] = bfhi(rw.y);
                  v[8 * i + 4] = bflo(rw.z); v[8 * i + 5] = bfhi(rw.z); v[8 * i + 6] = bflo(rw.w); v[8 * i + 7] = bfhi(rw.w); }
              float s = 0.f;
#pragma unroll
              for (int e = 0; e < 32; ++e) s += v[e];
              s += __shfl_xor(s, 1); s += __shfl_xor(s, 2); const float mu = s * (1.0f / 128.0f);
              float q = 0.f;
#pragma unroll
              for (int e = 0; e < 32; ++e) { v[e] -= mu; q += v[e] * v[e]; }
              q += __shfl_xor(q, 1); q += __shfl_xor(q, 2); const float rstd = 1.0f / sqrtf(q * (1.0f / 128.0f) + EPS);
              const float* gvp = gv + h * 128 + seg * 32;
#pragma unroll
              for (int e4 = 0; e4 < 8; ++e4) { const f32x4 g4 = *(const f32x4*)(gvp + 4 * e4);
#pragma unroll
                  for (int e = 0; e < 4; ++e) { const int d = seg * 32 + 4 * e4 + e;
                      *(LAS unsigned short*)(X + d * MXS + row * 2) = (unsigned short)f2bf(v[4 * e4 + e] * rstd * g4[e]); } }
            }
            __syncthreads();
            f32x4 acc[8]; mm128(X, Y, w, fr, fq, acc);
            const int p = 16 * w + fr; const float bias = bs[h * 128 + p];
            const bf16* up = HC + (size_t)(r0 + p) * AB_IN + h * 128 + fq * 4; bf16* op = AB + (size_t)(r0 + p) * D + h * 128 + fq * 4;
#pragma unroll
            for (int db = 0; db < 8; ++db) { const u32x2 uu = *(const u32x2*)(up + db * 16);
                u32x2 o; o.x = pk2(bflo(uu.x) * (acc[db][0] + bias), bfhi(uu.x) * (acc[db][1] + bias)); o.y = pk2(bflo(uu.y) * (acc[db][2] + bias), bfhi(uu.y) * (acc[db][3] + bias));
                *(u32x2*)(op + db * 16) = o; }
            __syncthreads();
        } else {
            const int gi = sub - 4, hh = 1 << gi; const int pos0 = r0 & (SEQ - 1);
#pragma unroll
            for (int i = 0; i < 4; ++i) { const int pc = tid + i * NTHR, row = pc >> 4, c16 = pc & 15;
                *(LAS u32x4*)(X + row * MXS + c16 * 16) = *(const u32x4*)(WPT + (gi * 128 + row) * 128 + c16 * 8); }
            for (int pc = tid; pc < 144 * 16; pc += NTHR) { const int zr = pc >> 4, c16 = pc & 15, pos = pos0 + zr - 8;
                u32x4 val = (u32x4){0u, 0u, 0u, 0u};
                if (pos >= 0 && pos < SEQ) val = *(const u32x4*)(HC + (size_t)(r0 + zr - 8) * AB_IN + 1024 + gi * 128 + c16 * 8);
                *(LAS u32x4*)(Z + zr * MXS + c16 * 16) = val; }
            __syncthreads();
            { const int i = tid >> 2, seg = tid & 3, pos = pos0 + i;
              const int hi = (pos + hh < SEQ) ? pos + hh : SEQ, lo = (pos - hh > 0) ? pos - hh : 0; const float inv = 1.0f / (float)(hi - lo);
#pragma unroll
              for (int gq = 0; gq < 4; ++gq) { const int cb = (seg * 32 + gq * 8) * 2;
                  float s[8];
#pragma unroll
                  for (int e = 0; e < 8; ++e) s[e] = 0.f;
                  for (int j = -hh; j < hh; ++j) { const u32x4 rw = *(const LAS u32x4*)(Z + (i + 8 + j) * MXS + cb);
                      s[0] += bflo(rw.x); s[1] += bfhi(rw.x); s[2] += bflo(rw.y); s[3] += bfhi(rw.y); s[4] += bflo(rw.z); s[5] += bfhi(rw.z); s[6] += bflo(rw.w); s[7] += bfhi(rw.w); }
                  const u32x4 zc = *(const LAS u32x4*)(Z + (i + 8) * MXS + cb);
                  u32x4 o; o.x = pk2(s[0] * inv - bflo(zc.x), s[1] * inv - bfhi(zc.x)); o.y = pk2(s[2] * inv - bflo(zc.y), s[3] * inv - bfhi(zc.y));
                  o.z = pk2(s[4] * inv - bflo(zc.z), s[5] * inv - bfhi(zc.z)); o.w = pk2(s[6] * inv - bflo(zc.w), s[7] * inv - bfhi(zc.w));
                  *(LAS u32x4*)(Y + i * MXS + cb) = o; }
            }
            __syncthreads();
            f32x4 acc[8]; mm128(X, Y, w, fr, fq, acc);
            const int i = 16 * w + fr; const float* pp = psc + gi * 128 + fq * 4; bf16* op = AB + (size_t)(r0 + i) * D + 512 + gi * 128 + fq * 4;
#pragma unroll
            for (int db = 0; db < 8; ++db) { const f32x4 sc = *(const f32x4*)(pp + db * 16); const f32x4 r = acc[db] * sc;
                u32x2 o; o.x = pk2(r[0], r[1]); o.y = pk2(r[2], r[3]); *(u32x2*)(op + db * 16) = o; }
            __syncthreads();
        }
    }
}

__device__ __forceinline__ void conv_phase(const Frame& F) {
    const bf16* T = (const bf16*)(F.ws + WS_T); const bf16* GB = (const bf16*)(F.ws + WS_GB); bf16* CV = (bf16*)(F.ws + WS_HN);
    const float* cw = F.in[11];
    for (int item = blockIdx.x * NTHR + F.tid; item < M * 128; item += F.G * NTHR) {
        const int row = item >> 7, c8 = (item & 127) * 8, pos = row & (SEQ - 1);
        const size_t o = (size_t)row * D + c8;
        const u32x4 z4 = (u32x4){0u, 0u, 0u, 0u};
        const u32x4 t1 = *(const u32x4*)(T + o), t0 = pos > 0 ? *(const u32x4*)(T + o - D) : z4, t2 = pos < SEQ - 1 ? *(const u32x4*)(T + o + D) : z4, gb = *(const u32x4*)(GB + o);
        const f32x4 w0a = *(const f32x4*)(cw + c8), w0b = *(const f32x4*)(cw + c8 + 4), w1a = *(const f32x4*)(cw + D + c8), w1b = *(const f32x4*)(cw + D + c8 + 4),
                    w2a = *(const f32x4*)(cw + 2 * D + c8), w2b = *(const f32x4*)(cw + 2 * D + c8 + 4);
        const f32x4 a0 = (f32x4){bflo(t0.x), bfhi(t0.x), bflo(t0.y), bfhi(t0.y)}, b0 = (f32x4){bflo(t0.z), bfhi(t0.z), bflo(t0.w), bfhi(t0.w)};
        const f32x4 a1 = (f32x4){bflo(t1.x), bfhi(t1.x), bflo(t1.y), bfhi(t1.y)}, b1 = (f32x4){bflo(t1.z), bfhi(t1.z), bflo(t1.w), bfhi(t1.w)};
        const f32x4 a2 = (f32x4){bflo(t2.x), bfhi(t2.x), bflo(t2.y), bfhi(t2.y)}, b2 = (f32x4){bflo(t2.z), bfhi(t2.z), bflo(t2.w), bfhi(t2.w)};
        const f32x4 ga = (f32x4){bflo(gb.x), bfhi(gb.x), bflo(gb.y), bfhi(gb.y)}, gbb = (f32x4){bflo(gb.z), bfhi(gb.z), bflo(gb.w), bfhi(gb.w)};
        const f32x4 ra = ga * (a0 * w0a + a1 * w1a + a2 * w2a), rb = gbb * (b0 * w0b + b1 * w1b + b2 * w2b);
        u32x4 ov; ov.x = pk2(ra[0], ra[1]); ov.y = pk2(ra[2], ra[3]); ov.z = pk2(rb[0], rb[1]); ov.w = pk2(rb[2], rb[3]);
        *(u32x4*)(CV + o) = ov;
    }
}

struct Args { const float* in[16]; float* out; unsigned char* ws; };
__global__ void __launch_bounds__(NTHR, 2) mk_fwd(Args args) {
    extern __shared__ __attribute__((aligned(16))) unsigned char lds_raw[];
    cg::grid_group grid = cg::this_grid();
    Frame F;
    F.lds = (LAS unsigned char*)lds_raw;
    F.tid = threadIdx.x; F.lane = F.tid & 63; F.wave = __builtin_amdgcn_readfirstlane(F.tid >> 6); F.G = gridDim.x;
#pragma unroll
    for (int i = 0; i < 16; ++i) F.in[i] = args.in[i];
    F.out = args.out; F.ws = args.ws;
    unsigned char* ws = args.ws;
    bf16* HN = (bf16*)(ws + WS_HN); bf16* MB = (bf16*)(ws + WS_MB); bf16* HF = (bf16*)(ws + WS_HF); float* PART = (float*)(ws + WS_PART);
    const float* ng = F.in[2];
    const int bid = (int)blockIdx.x;

    volatile LAS unsigned* bst = (volatile LAS unsigned*)(F.lds + LDS_BYTES - 64);
    if (F.tid < 16) bst[F.tid] = 0u;
    unsigned* barw = (unsigned*)ws;
    if (bid == 0) for (int i = F.tid; i < XCD_BAR_WORDS; i += NTHR) __hip_atomic_store(barw + i, 0u, __ATOMIC_RELAXED, __HIP_MEMORY_SCOPE_AGENT);
    p0_prologue(F);
    grid.sync();
    const XcdBarrier xbar = xcd_barrier_post(barw, bst);
#define GRID_BAR() xcd_barrier(xbar)
    { pg8::Gemm g{HN, (const bf16*)(ws + WS_W1), M, AB_IN, D}; pg8::StaticOrder S; S.init(M, AB_IN, F.G, bid);
      pg8::EpiAct E{(bf16*)(ws + WS_HC), AB_IN, 4};
      pg8::gemm_phase<pg8::EpiAct, pg8::StaticOrder, true, true>(F.lds, g, S, E); }
    GRID_BAR();
    mixer_phase(F);
    GRID_BAR();
    { pg8::Gemm g{HN, (const bf16*)(ws + WS_WO0), M, D, D}; pg8::StaticOrder S; S.init(M, D, F.G, bid);
      pg8::EpiStats E{MB, PART};
      pg8::gemm_phase<pg8::EpiStats, pg8::StaticOrder, true, true>(F.lds, g, S, E); }
    GRID_BAR();
    norm_phase<1>(F, ng + 1 * D, ng + 2 * D);
    GRID_BAR();
    { pg8::Gemm g{HN, (const bf16*)(ws + WS_WGU0), M, 2 * FF, D}; pg8::StaticOrder S; S.init(M, 2 * FF, F.G, bid);
      pg8::EpiSwiglu E{HF, FF};
      pg8::gemm_phase<pg8::EpiSwiglu, pg8::StaticOrder, true, true>(F.lds, g, S, E); }
    GRID_BAR();
    { pg8::Gemm g{HF, (const bf16*)(ws + WS_WD0), M, D, FF}; pg8::StaticOrder S; S.init(M, D, F.G, bid);
      pg8::EpiStats E{MB, PART};
      pg8::gemm_phase<pg8::EpiStats, pg8::StaticOrder, true, true>(F.lds, g, S, E); }
    GRID_BAR();
    norm_phase<2>(F, ng + 3 * D, ng + 4 * D);
    GRID_BAR();
    { pg8::Gemm g{HN, (const bf16*)(ws + WS_WCI), M, CIN, D}; pg8::StaticOrder S; S.init(M, CIN, F.G, bid);
      pg8::EpiMulSplit E{(bf16*)(ws + WS_T), (bf16*)(ws + WS_GB)};
      pg8::gemm_phase<pg8::EpiMulSplit, pg8::StaticOrder, true, true>(F.lds, g, S, E); }
    GRID_BAR();
    conv_phase(F);
    GRID_BAR();
    { pg8::Gemm g{HN, (const bf16*)(ws + WS_WCO), M, D, D}; pg8::StaticOrder S; S.init(M, D, F.G, bid);
      pg8::EpiStats E{MB, PART};
      pg8::gemm_phase<pg8::EpiStats, pg8::StaticOrder, true, true>(F.lds, g, S, E); }
    GRID_BAR();
    norm_phase<2>(F, ng + 5 * D, ng + 6 * D);
    GRID_BAR();
    { pg8::Gemm g{HN, (const bf16*)(ws + WS_WGU1), M, 2 * FF, D}; pg8::StaticOrder S; S.init(M, 2 * FF, F.G, bid);
      pg8::EpiSwiglu E{HF, FF};
      pg8::gemm_phase<pg8::EpiSwiglu, pg8::StaticOrder, true, true>(F.lds, g, S, E); }
    GRID_BAR();
    { pg8::Gemm g{HF, (const bf16*)(ws + WS_WD1), M, D, FF}; pg8::StaticOrder S; S.init(M, D, F.G, bid);
      pg8::EpiStats E{MB, PART};
      pg8::gemm_phase<pg8::EpiStats, pg8::StaticOrder, true, true>(F.lds, g, S, E); }
    GRID_BAR();
    norm_phase<3>(F, ng + 7 * D, nullptr);
}

extern "C" void kernel_launch(void* const* d_in, const int* in_sizes, int n_in, void* d_out, int out_size, void* d_ws, size_t ws_size, hipStream_t stream) {
    static int grid = 0;
    if (grid == 0) {
        if (n_in != 16 || out_size != M * D || ws_size < WS_END) { fprintf(stderr, "kernel_launch: unexpected shapes (n_in %d, out %d, ws %zu); nothing launched\n", n_in, out_size, ws_size); grid = -1; return; }
        int dev = 0, cus = 0, per_cu = 0;
        if (hipGetDevice(&dev) != hipSuccess || hipDeviceGetAttribute(&cus, hipDeviceAttributeMultiprocessorCount, dev) != hipSuccess) { grid = -1; return; }
        if (hipFuncSetAttribute((const void*)mk_fwd, hipFuncAttributeMaxDynamicSharedMemorySize, LDS_BYTES) != hipSuccess) { fprintf(stderr, "kernel_launch: hipFuncSetAttribute failed\n"); grid = -1; return; }
        if (hipOccupancyMaxActiveBlocksPerMultiprocessor(&per_cu, (const void*)mk_fwd, NTHR, LDS_BYTES) != hipSuccess || per_cu < 1) { fprintf(stderr, "kernel_launch: occupancy query says %d\n", per_cu); per_cu = 1; }
        (void)hipGetLastError();
        grid = cus;
    }
    if (grid < 0) return;
    Args a{};
    for (int i = 0; i < 16; ++i) a.in[i] = (const float*)d_in[i];
    a.out = (float*)d_out; a.ws = (unsigned char*)d_ws;
    void* kargs[] = {&a};
    hipError_t e = hipLaunchCooperativeKernel((const void*)mk_fwd, dim3(grid), dim3(NTHR), kargs, LDS_BYTES, stream);
    if (e != hipSuccess) fprintf(stderr, "kernel_launch: cooperative launch failed: %s (grid %d)\n", hipGetErrorString(e), grid);
}
```

```cpp
#include <hip/hip_runtime.h>
#include <hip/hip_cooperative_groups.h>
#include <cstdio>
#include <cstdint>
namespace cg = cooperative_groups;

namespace pg8 {
#define PG8_LAS __attribute__((address_space(3)))
typedef unsigned short bf16_t;
typedef short bf16x8 __attribute__((ext_vector_type(8)));
typedef float f32x4 __attribute__((ext_vector_type(4)));
typedef unsigned u32x4 __attribute__((ext_vector_type(4)));
typedef unsigned u32x2 __attribute__((ext_vector_type(2)));
constexpr int BM = 256, BK = 64, HALF = 128, HTB = HALF * BK * 2  , STAGE_BYTES = 8 * HTB, NXCD = 8, WGM = 8;

__host__ __device__ __forceinline__ int lds_byte(int r, int c) { const int st = (r >> 4) * 2 + (c >> 5), rr = r & 15, cc = c & 31, ob = rr * 64 + cc * 2; return st * 1024 + (ob ^ (((ob >> 9) & 1) << 5)); }
__host__ __device__ __forceinline__ void stage_rc(int b, int& R, int& C) { const int st = b / 1024, sb = b % 1024, swz = sb ^ (((sb >> 9) & 1) << 5); R = (st >> 1) * 16 + swz / 64; C = (st & 1) * 32 + (swz % 64) / 2; }
__host__ __device__ __forceinline__ int perm32(int rho) { const int n = rho >> 4, i = rho & 15; return 8 * (i >> 2) + 4 * n + (i & 3); }

struct Unit { int pm, pn; };
struct Gemm { const bf16_t* A; const bf16_t* Bt; int M, N, K; };

struct StaticOrder {
    int nM, nN, nwg, G, c;
    __host__ __device__ void init(int M, int N, int G_, int c_) { nM = M / BM; nN = N / BM; nwg = nM * nN; G = G_; c = c_; }
    __host__ __device__ bool next(int i, Unit& u) const {
        const long L = (long)i * G + c; if (L >= nwg) return false;
        int wgid = (int)L; { const int q = nwg / NXCD, r = nwg % NXCD, xcd = wgid % NXCD, off = wgid / NXCD; wgid = (xcd < r ? xcd * (q + 1) : r * (q + 1) + (xcd - r) * q) + off; }
        const int nig = WGM * nN, gid = wgid / nig, fm = gid * WGM, gsz = (nM - fm) < WGM ? (nM - fm) : WGM;
        u.pm = fm + ((wgid % nig) % gsz); u.pn = (wgid % nig) / gsz; return true;
    }
    __device__ __forceinline__ void a_ready(const Unit&) const {}
    __device__ __forceinline__ void done(const Unit&) const {}
};

__device__ __forceinline__ unsigned cvt_pk_bf16(float lo, float hi) { unsigned r; asm volatile("v_cvt_pk_bf16_f32 %0, %1, %2" : "=v"(r) : "v"(lo), "v"(hi)); return r; }
__device__ __forceinline__ u32x4 pack8(const f32x4 v0, const f32x4 v1) { u32x4 w; w.x = cvt_pk_bf16(v0[0], v0[1]); w.y = cvt_pk_bf16(v0[2], v0[3]); w.z = cvt_pk_bf16(v1[0], v1[1]); w.w = cvt_pk_bf16(v1[2], v1[3]); return w; }
__device__ __forceinline__ float gelu_tanh(float x) { const float t = x * (1.0f + 0.044715f * x * x) * (-2.302208198f); return x * __builtin_amdgcn_rcpf(1.0f + __builtin_amdgcn_exp2f(t)); }
__device__ __forceinline__ float silu_f(float x) { return x * __builtin_amdgcn_rcpf(1.0f + __builtin_amdgcn_exp2f(x * (-1.4426950409f))); }
__device__ __forceinline__ f32x4 gelu4(const f32x4 v) { return (f32x4){gelu_tanh(v[0]), gelu_tanh(v[1]), gelu_tanh(v[2]), gelu_tanh(v[3])}; }
__device__ __forceinline__ f32x4 silu4(const f32x4 v) { return (f32x4){silu_f(v[0]), silu_f(v[1]), silu_f(v[2]), silu_f(v[3])}; }

struct EpiAct {
    static constexpr bool PERM = true, AFTER_DRAIN = false;
    bf16_t* O; int ldc; int n_act;
    __device__ __forceinline__ void operator()(const f32x4 (&acc)[2][2][4][2], const Unit& u, int wr, int wc, int fr, int fq) const {
        const int row0 = u.pm * BM + wr * 64 + fr, col0 = u.pn * BM + wc * 32 + 8 * fq; const bool act = u.pn < n_act;
#pragma unroll
        for (int ai = 0; ai < 2; ++ai)
#pragma unroll
            for (int m = 0; m < 4; ++m) { bf16_t* rowp = O + (size_t)(row0 + ai * HALF + m * 16) * ldc + col0;
#pragma unroll
                for (int bj = 0; bj < 2; ++bj) { f32x4 v0 = acc[ai][bj][m][0], v1 = acc[ai][bj][m][1];
                    if (act) { v0 = gelu4(v0); v1 = gelu4(v1); }
                    *(u32x4*)(rowp + bj * HALF) = pack8(v0, v1); } }
    }
};
struct EpiStats {
    static constexpr bool PERM = true, AFTER_DRAIN = false;
    bf16_t* O; float* part;
    __device__ __forceinline__ void operator()(const f32x4 (&acc)[2][2][4][2], const Unit& u, int wr, int wc, int fr, int fq) const {
        const int row0 = u.pm * BM + wr * 64 + fr, col0 = u.pn * BM + wc * 32 + 8 * fq;
#pragma unroll
        for (int ai = 0; ai < 2; ++ai)
#pragma unroll
            for (int m = 0; m < 4; ++m) { const int row = row0 + ai * HALF + m * 16; bf16_t* rowp = O + (size_t)row * 1024 + col0; float s = 0.f;
#pragma unroll
                for (int bj = 0; bj < 2; ++bj) { const f32x4 v0 = acc[ai][bj][m][0], v1 = acc[ai][bj][m][1];
                    s += (v0[0] * v0[0] + v0[1] * v0[1]) + (v0[2] * v0[2] + v0[3] * v0[3]) + (v1[0] * v1[0] + v1[1] * v1[1]) + (v1[2] * v1[2] + v1[3] * v1[3]);
                    *(u32x4*)(rowp + bj * HALF) = pack8(v0, v1); }
                s += __shfl_xor(s, 16); s += __shfl_xor(s, 32);
                if (fq == 0) part[(size_t)row * 16 + u.pn * 4 + wc] = s; }
    }
};
struct EpiSwiglu {
    static constexpr bool PERM = true, AFTER_DRAIN = false;
    bf16_t* O; int ldc; bool dry;
    __device__ __forceinline__ void operator()(const f32x4 (&acc)[2][2][4][2], const Unit& u, int wr, int wc, int fr, int fq) const {
        const int row0 = u.pm * BM + wr * 64 + fr, col0 = u.pn * HALF + wc * 32 + 8 * fq;
        if (dry) { if (acc[0][0][0][0][0] == 1.2345e-30f) O[0] = 0; return; }
#pragma unroll
        for (int ai = 0; ai < 2; ++ai)
#pragma unroll
            for (int m = 0; m < 4; ++m) { bf16_t* rowp = O + (size_t)(row0 + ai * HALF + m * 16) * ldc + col0;
                const f32x4 v0 = silu4(acc[ai][0][m][0]) * acc[ai][1][m][0], v1 = silu4(acc[ai][0][m][1]) * acc[ai][1][m][1];
                *(u32x4*)rowp = pack8(v0, v1); }
    }
};
struct EpiMulSplit {
    static constexpr bool PERM = true, AFTER_DRAIN = false;
    bf16_t* T; bf16_t* GB;
    __device__ __forceinline__ void operator()(const f32x4 (&acc)[2][2][4][2], const Unit& u, int wr, int wc, int fr, int fq) const {
        const int row0 = u.pm * BM + wr * 64 + fr;
        if (u.pn < 8) { const int col0 = u.pn * HALF + wc * 32 + 8 * fq;
#pragma unroll
            for (int ai = 0; ai < 2; ++ai)
#pragma unroll
                for (int m = 0; m < 4; ++m) { bf16_t* rowp = T + (size_t)(row0 + ai * HALF + m * 16) * 1024 + col0;
                    *(u32x4*)rowp = pack8(acc[ai][0][m][0] * acc[ai][1][m][0], acc[ai][0][m][1] * acc[ai][1][m][1]); }
        } else { const int col0 = (u.pn - 8) * BM + wc * 32 + 8 * fq;
#pragma unroll
            for (int ai = 0; ai < 2; ++ai)
#pragma unroll
                for (int m = 0; m < 4; ++m) { bf16_t* rowp = GB + (size_t)(row0 + ai * HALF + m * 16) * 1024 + col0;
#pragma unroll
                    for (int bj = 0; bj < 2; ++bj) *(u32x4*)(rowp + bj * HALF) = pack8(acc[ai][bj][m][0], acc[ai][bj][m][1]); }
        }
    }
};

template <class Epi, class Sched, bool ALIGN_EPI = false, bool SP2 = false>
__device__ __forceinline__ void gemm_phase(PG8_LAS unsigned char* lds, const Gemm g, const Sched& S, const Epi& E) {
    const int tid = threadIdx.x, wid = __builtin_amdgcn_readfirstlane(tid >> 6), lane = tid & 63, wr = wid >> 2, wc = wid & 3, fr = lane & 15, fq = lane >> 4;
    const int K = g.K, nt = K / BK;
    unsigned voffA[2], voffB[2];
#pragma unroll
    for (int i = 0; i < 2; ++i) { int R, C; stage_rc(tid * 16 + i * 8192, R, C); const int Rb = Epi::PERM ? ((R & ~31) + perm32(R & 31)) : R;
        voffA[i] = (unsigned)(R * K + C) * 2u; voffB[i] = (unsigned)(Rb * K + C) * 2u; }
    const size_t kstep = (size_t)(BK * 2);
    const size_t hstep = (size_t)HALF * K * 2;
    const size_t tstep = 2 * hstep;
    const unsigned ldsw = (unsigned)wid * 1024u;
    const int aoff = lds_byte(wr * 64 + fr, fq * 8), boff = lds_byte(wc * 32 + fr, fq * 8);
#define PG8_SA(b, h) (((b) * 2 + (h)) * HTB)
#define PG8_SB(b, h) ((4 + (b) * 2 + (h)) * HTB)
#define PG8_STAGE(bufoff, gbase, voff) do { _Pragma("unroll") for (int _i = 0; _i < 2; ++_i) \
        __builtin_amdgcn_global_load_lds((const unsigned*)((const char*)(gbase) + (voff)[_i]), (PG8_LAS unsigned*)(lds + (bufoff) + ldsw + _i * 8192), 16, 0, 0); } while (0)
#define PG8_LDA(dst, b, h) do { _Pragma("unroll") for (int m = 0; m < 4; ++m) _Pragma("unroll") for (int k = 0; k < 2; ++k) dst[m][k] = *(const PG8_LAS bf16x8*)(lds + PG8_SA(b, h) + aoff + m * 2048 + k * 1024); } while (0)
#define PG8_LDB(dst, b, h) do { _Pragma("unroll") for (int n = 0; n < 2; ++n) _Pragma("unroll") for (int k = 0; k < 2; ++k) dst[n][k] = *(const PG8_LAS bf16x8*)(lds + PG8_SB(b, h) + boff + n * 2048 + k * 1024); } while (0)
#define PG8_MMA(ai, bj, At, Bt) do { __builtin_amdgcn_s_setprio(1); _Pragma("unroll") for (int m = 0; m < 4; ++m) _Pragma("unroll") for (int n = 0; n < 2; ++n) _Pragma("unroll") for (int k = 0; k < 2; ++k) \
        acc[ai][bj][m][n] = __builtin_amdgcn_mfma_f32_16x16x32_bf16(Bt[n][k], At[m][k], acc[ai][bj][m][n], 0, 0, 0); __builtin_amdgcn_s_setprio(0); } while (0)
#define PG8_WAIT_V(n) asm volatile("s_waitcnt vmcnt(" #n ")" ::: "memory")
#define PG8_WAIT_L(n) asm volatile("s_waitcnt lgkmcnt(" #n ")" ::: "memory")
#define PG8_BAR __builtin_amdgcn_s_barrier()
#define PG8_SCHED __builtin_amdgcn_sched_barrier(0)
    Unit cur, nxt; int ui = 0;
    if (!S.next(0, cur)) return;
    f32x4 acc[2][2][4][2];
#pragma unroll
    for (int a = 0; a < 2; ++a)
#pragma unroll
        for (int b = 0; b < 2; ++b)
#pragma unroll
            for (int m = 0; m < 4; ++m)
#pragma unroll
                for (int n = 0; n < 2; ++n) acc[a][b][m][n] = (f32x4){0.f, 0.f, 0.f, 0.f};
    bf16x8 At[4][2], B0[2][2], B1[2][2];
    const char* cA = (const char*)g.A + (size_t)cur.pm * tstep; const char* cB = (const char*)g.Bt + (size_t)cur.pn * tstep;
    S.a_ready(cur);
    if constexpr (SP2) {
        PG8_STAGE(PG8_SB(0, 0), cB, voffB); PG8_STAGE(PG8_SB(0, 1), cB + hstep, voffB); PG8_STAGE(PG8_SA(0, 0), cA, voffA); PG8_STAGE(PG8_SA(0, 1), cA + hstep, voffA);
        if (wr == 1) PG8_BAR;
        PG8_WAIT_V(2); PG8_BAR;
        PG8_STAGE(PG8_SB(1, 0), cB + kstep, voffB); PG8_STAGE(PG8_SA(1, 0), cA + kstep, voffA); PG8_STAGE(PG8_SB(1, 1), cB + hstep + kstep, voffB);
        PG8_WAIT_V(6); PG8_BAR;
    } else {
        PG8_STAGE(PG8_SB(0, 0), cB, voffB); PG8_STAGE(PG8_SA(0, 0), cA, voffA); PG8_STAGE(PG8_SB(0, 1), cB + hstep, voffB); PG8_STAGE(PG8_SA(0, 1), cA + hstep, voffA);
        if (wr == 1) PG8_BAR;
        PG8_WAIT_V(4); PG8_BAR;
        PG8_STAGE(PG8_SB(1, 0), cB + kstep, voffB); PG8_STAGE(PG8_SA(1, 0), cA + kstep, voffA); PG8_STAGE(PG8_SB(1, 1), cB + hstep + kstep, voffB);
        PG8_WAIT_V(6); PG8_BAR;
    }
    for (;;) {
        const bool has_next = S.next(ui + 1, nxt);
        const char* nA = has_next ? (const char*)g.A + (size_t)nxt.pm * tstep : cA; const char* nB = has_next ? (const char*)g.Bt + (size_t)nxt.pn * tstep : cB;
        for (int t = 0; t < nt; t += 2) {
            const bool last = (t == nt - 2);
            const char* a1 = cA + (size_t)(t + 1) * kstep;
            const char* a2 = last ? nA : cA + (size_t)(t + 2) * kstep; const char* b2 = last ? nB : cB + (size_t)(t + 2) * kstep;
            const char* a3 = a2 + kstep; const char* b3 = b2 + kstep;
            if (last && has_next) S.a_ready(nxt);
            if constexpr (SP2) {
            PG8_LDB(B0, 0, 0); PG8_LDB(B1, 0, 1); PG8_SCHED; PG8_LDA(At, 0, 0); PG8_STAGE(PG8_SA(1, 1), a1 + hstep, voffA);
            PG8_WAIT_V(8); PG8_WAIT_L(0); PG8_BAR; PG8_MMA(0, 0, At, B0); PG8_MMA(0, 1, At, B1); PG8_BAR; PG8_SCHED;
            PG8_LDA(At, 0, 1); PG8_STAGE(PG8_SB(0, 0), b2, voffB); PG8_STAGE(PG8_SB(0, 1), b2 + hstep, voffB); PG8_STAGE(PG8_SA(0, 0), a2, voffA);
            PG8_WAIT_V(8); PG8_WAIT_L(0); PG8_BAR; PG8_MMA(1, 0, At, B0); PG8_MMA(1, 1, At, B1); PG8_BAR; PG8_SCHED;
            PG8_LDB(B0, 1, 0); PG8_LDB(B1, 1, 1); PG8_SCHED; PG8_LDA(At, 1, 0); PG8_STAGE(PG8_SA(0, 1), a2 + hstep, voffA);
            PG8_WAIT_V(8); PG8_WAIT_L(0); PG8_BAR; PG8_MMA(0, 0, At, B0); PG8_MMA(0, 1, At, B1); PG8_BAR; PG8_SCHED;
            PG8_LDA(At, 1, 1); PG8_STAGE(PG8_SB(1, 0), b3, voffB); PG8_STAGE(PG8_SB(1, 1), b3 + hstep, voffB); PG8_STAGE(PG8_SA(1, 0), a3, voffA);
            PG8_WAIT_V(8); PG8_WAIT_L(0); PG8_BAR; PG8_MMA(1, 0, At, B0); PG8_MMA(1, 1, At, B1); PG8_BAR; PG8_SCHED;
            } else {
            PG8_LDB(B0, 0, 0); PG8_SCHED; PG8_LDA(At, 0, 0); PG8_STAGE(PG8_SA(1, 1), a1 + hstep, voffA);
            PG8_WAIT_L(8); PG8_BAR; PG8_WAIT_L(0); PG8_MMA(0, 0, At, B0); PG8_BAR; PG8_SCHED;
            PG8_LDB(B1, 0, 1); PG8_STAGE(PG8_SB(0, 0), b2, voffB);
            PG8_BAR; PG8_WAIT_L(0); PG8_MMA(0, 1, At, B1); PG8_BAR;
            PG8_LDA(At, 0, 1); PG8_STAGE(PG8_SA(0, 0), a2, voffA);
            PG8_BAR; PG8_WAIT_L(0); PG8_MMA(1, 0, At, B0); PG8_BAR; PG8_SCHED;
            PG8_STAGE(PG8_SB(0, 1), b2 + hstep, voffB);
            PG8_WAIT_V(6); PG8_BAR; PG8_MMA(1, 1, At, B1); PG8_BAR;
            PG8_LDB(B0, 1, 0); PG8_SCHED; PG8_LDA(At, 1, 0); PG8_STAGE(PG8_SA(0, 1), a2 + hstep, voffA);
            PG8_WAIT_L(8); PG8_BAR; PG8_WAIT_L(0); PG8_MMA(0, 0, At, B0); PG8_BAR; PG8_SCHED;
            PG8_LDB(B1, 1, 1); PG8_STAGE(PG8_SB(1, 0), b3, voffB);
            PG8_BAR; PG8_WAIT_L(0); PG8_MMA(0, 1, At, B1); PG8_BAR;
            PG8_LDA(At, 1, 1); PG8_STAGE(PG8_SA(1, 0), a3, voffA);
            PG8_BAR; PG8_WAIT_L(0); PG8_MMA(1, 0, At, B0); PG8_BAR; PG8_SCHED;
            PG8_STAGE(PG8_SB(1, 1), b3 + hstep, voffB);
            PG8_WAIT_V(6); PG8_BAR; PG8_MMA(1, 1, At, B1); PG8_BAR;
            }
        }
        if constexpr (ALIGN_EPI) { if (wr == 0) PG8_BAR; }
        if constexpr (!Epi::AFTER_DRAIN) { E(acc, cur, wr, wc, fr, fq); S.done(cur); }
        if (!has_next) break;
#pragma unroll
        for (int a = 0; a < 2; ++a)
#pragma unroll
            for (int b = 0; b < 2; ++b)
#pragma unroll
                for (int m = 0; m < 4; ++m)
#pragma unroll
                    for (int n = 0; n < 2; ++n) acc[a][b][m][n] = (f32x4){0.f, 0.f, 0.f, 0.f};
        cur = nxt; cA = nA; cB = nB; ++ui;
        if constexpr (ALIGN_EPI) { if (wr == 1) PG8_BAR; }
    }
    PG8_WAIT_V(0);
    if constexpr (!ALIGN_EPI) { if (wr == 0) PG8_BAR; }
    PG8_BAR;
#undef PG8_SA
#undef PG8_SB
#undef PG8_STAGE
#undef PG8_LDA
#undef PG8_LDB
#undef PG8_MMA
#undef PG8_WAIT_V
#undef PG8_WAIT_L
#undef PG8_BAR
#undef PG8_SCHED
}
}

constexpr int D = 1024, SEQ = 4096, MP = 8 * SEQ, MS = 4 * SEQ, M = MP + MS;
constexpr int AB_IN = 1536, FF = 2816, CIN = 3072;
constexpr float EPS = 1e-6f;
constexpr int NWAVES = 8, NTHR = 512;

constexpr size_t MiB = 1u << 20;
constexpr size_t WS_WSB = 1 * MiB, WS_WPT = 1 * MiB + 128 * 1024;
constexpr size_t WS_W1 = 2 * MiB, WS_WO0 = 5 * MiB, WS_WGU0 = 7 * MiB, WS_WD0 = 18 * MiB, WS_WCI = 24 * MiB, WS_WCO = 30 * MiB, WS_WGU1 = 32 * MiB, WS_WD1 = 43 * MiB;
constexpr size_t WS_RINV = 48 * MiB + 512 * 1024;
constexpr size_t WS_PART = 49 * MiB;
constexpr size_t WS_HF = 52 * MiB;
constexpr size_t WS_HC = WS_HF, WS_T = WS_HF, WS_GB = WS_HF + 96 * MiB;
constexpr size_t WS_HN = 316 * MiB;
constexpr size_t WS_MB = 412 * MiB;
constexpr size_t WS_END = 508 * MiB;
static_assert(WS_WD1 + (size_t)D * FF * 2 <= WS_RINV && WS_RINV + (size_t)M * 4 <= WS_PART && WS_PART + (size_t)M * 64 <= WS_HF && WS_HF + (size_t)M * FF * 2 <= WS_HN && WS_HN + (size_t)M * D * 2 <= WS_MB && WS_MB + (size_t)M * D * 2 <= WS_END, "d_ws map");
static_assert(WS_HC + (size_t)M * AB_IN * 2 <= WS_HN && WS_GB + (size_t)M * D * 2 <= WS_HN, "overlay map");

constexpr int LDS_BYTES = 147456;

#define LAS __attribute__((address_space(3)))
typedef unsigned short bf16;
typedef float f32x4 __attribute__((ext_vector_type(4)));
typedef unsigned u32x4 __attribute__((ext_vector_type(4)));
typedef unsigned u32x2 __attribute__((ext_vector_type(2)));
typedef short bf16x8 __attribute__((ext_vector_type(8)));
#define LDS_WAIT() asm volatile("s_waitcnt lgkmcnt(0)" ::: "memory")
__device__ __forceinline__ unsigned f2bf(float f) { unsigned u = __builtin_bit_cast(unsigned, f); return (u + 0x7fffu + ((u >> 16) & 1u)) >> 16; }
__device__ __forceinline__ unsigned pk2(float lo, float hi) { return f2bf(lo) | (f2bf(hi) << 16); }
__device__ __forceinline__ float bflo(unsigned u) { return __uint_as_float(u << 16); }
__device__ __forceinline__ float bfhi(unsigned u) { return __uint_as_float(u & 0xffff0000u); }
__device__ __forceinline__ float wave_sum(float v) {
#pragma unroll
    for (int o = 1; o < 64; o <<= 1) v += __shfl_xor(v, o);
    return v;
}


#define XB_TMO      128
#define XB_XCNT(j)  (256  + 64 * (j))
#define XB_XSUB(j)  (1280 + 64 * (j))
#define XB_XGEN(j)  (2304 + 64 * (j))
#define XB_TOP      3328
#define XB_TOPGEN   3392
#define XCD_BAR_WORDS 3456
#define XB_SPIN_CAP (1u << 18)
__device__ __forceinline__ unsigned xb_ld(unsigned* p)              { return __hip_atomic_load(p, __ATOMIC_RELAXED, __HIP_MEMORY_SCOPE_AGENT); }
__device__ __forceinline__ unsigned xb_add(unsigned* p, unsigned v) { return __hip_atomic_fetch_add(p, v, __ATOMIC_RELAXED, __HIP_MEMORY_SCOPE_AGENT); }
__device__ __forceinline__ unsigned xb_xcc_id() { return (unsigned)__builtin_amdgcn_s_getreg((3 << 11) | 20) & 0xFu; }
#define XB_SPIN(cond, bar) do { unsigned _sp = 0; while (cond) { __builtin_amdgcn_s_sleep(1); \
    if ((++_sp & 255u) == 0u) { if (xb_ld(&(bar)[XB_TMO])) break; if (_sp > XB_SPIN_CAP) { atomicAdd(&(bar)[XB_TMO], 1u); break; } } } } while (0)
struct XcdBarrier { unsigned* bar; unsigned x; volatile LAS unsigned* st; };
__device__ __forceinline__ XcdBarrier xcd_barrier_post(unsigned* bar, volatile LAS unsigned* st) {
    XcdBarrier b; b.bar = bar; b.x = xb_xcc_id(); b.st = st;
    if (threadIdx.x == 0) (void)xb_add(&bar[XB_XCNT(b.x)], 1u);
    return b;
}
__device__ __forceinline__ void xcd_barrier_complete(unsigned* bar, unsigned x, unsigned& nloc, unsigned& nx) {
    const unsigned G = gridDim.x * gridDim.y * gridDim.z;
    unsigned sum, cnt, mine, sp = 0u;
    for (;;) {
        sum = 0u; cnt = 0u; mine = 0u;
#pragma unroll
        for (unsigned j = 0; j < 16; ++j) { const unsigned c = xb_ld(&bar[XB_XCNT(j)]); sum += c; cnt += (c > 0u) ? 1u : 0u; mine = (j == x) ? c : mine; }
        if (sum == G) break;
        __builtin_amdgcn_s_sleep(1);
        if ((++sp & 255u) == 0u) { if (xb_ld(&bar[XB_TMO])) break; if (sp > XB_SPIN_CAP) { atomicAdd(&bar[XB_TMO], 1u); break; } }
    }
    nloc = mine > 0u ? mine : 1u; nx = cnt > 0u ? cnt : 1u;
}
__device__ __forceinline__ void xcd_barrier(const XcdBarrier& b) {
    asm volatile("s_waitcnt vmcnt(0)" ::: "memory");
    __syncthreads();
    if (threadIdx.x == 0) {
        unsigned* bar = b.bar;
        __builtin_amdgcn_s_waitcnt(0);
        unsigned nloc = b.st[0], nx = b.st[1];
        if (nloc == 0u) { xcd_barrier_complete(bar, b.x, nloc, nx); b.st[0] = nloc; b.st[1] = nx; }
        const unsigned old = xb_add(&bar[XB_XSUB(b.x)], 1u);
        const unsigned gen = old / nloc;
        if (old + 1u == (gen + 1u) * nloc) {
            __builtin_amdgcn_fence(__ATOMIC_RELEASE, "agent");
            asm volatile("s_waitcnt vmcnt(0)" ::: "memory");
            const unsigned og = xb_add(&bar[XB_TOP], 1u);
            const unsigned tg = og / nx;
            if (og + 1u == (tg + 1u) * nx) xb_add(&bar[XB_TOPGEN], 1u);
            else XB_SPIN(xb_ld(&bar[XB_TOPGEN]) == tg, bar);
            __builtin_amdgcn_fence(__ATOMIC_ACQUIRE, "agent");
            xb_add(&bar[XB_XGEN(b.x)], 1u);
            asm volatile("s_waitcnt vmcnt(0)" ::: "memory");
        } else {
            XB_SPIN(xb_ld(&bar[XB_XGEN(b.x)]) == gen, bar);
            __builtin_amdgcn_fence(__ATOMIC_ACQUIRE, "agent");
            asm volatile("s_waitcnt vmcnt(0)" ::: "memory");
        }
    }
    __syncthreads();
}

struct Frame {
    LAS unsigned char* lds;
    int tid, lane, wave, G;
    const float* in[16]; float* out; unsigned char* ws;
};

__device__ __forceinline__ int map_row(int mode, int n0) {
    if (mode == 0) return n0;
    if (mode == 1) return 256 * (n0 >> 7) + (n0 & 127);
    if (mode == 2) return 256 * (n0 >> 7) + 128 + (n0 & 127);
    if (n0 < 1024) return 2048 + n0;
    if (n0 < 2048) { const int j = n0 - 1024; return 256 * (j >> 7) + (j & 127); }
    { const int j = n0 - 2048; return 256 * (j >> 7) + 128 + (j & 127); }
}
__device__ __forceinline__ void p0_transpose_item(const float* W, int K, int N, bf16* WT, int mode, LAS float* scr, int item, int lane) {
    const int nblk = N / 32, kb = item / nblk, nb = item % nblk, k0 = 64 * kb, n0 = 32 * nb; const int drow0 = map_row(mode, n0);
#pragma unroll 8
    for (int i = 0; i < 32; ++i) { const int kk = 2 * i + (lane >> 5); scr[kk * 33 + (lane & 31)] = W[(size_t)(k0 + kk) * N + n0 + (lane & 31)]; }
    LDS_WAIT(); asm volatile("" ::: "memory");
    const int c = lane & 7;
#pragma unroll
    for (int j = 0; j < 4; ++j) { const int n = (lane >> 3) + 8 * j; const LAS float* s = scr + (8 * c) * 33 + n;
        u32x4 o; o.x = pk2(s[0 * 33], s[1 * 33]); o.y = pk2(s[2 * 33], s[3 * 33]); o.z = pk2(s[4 * 33], s[5 * 33]); o.w = pk2(s[6 * 33], s[7 * 33]);
        *(u32x4*)(WT + (size_t)(drow0 + n) * K + k0 + 8 * c) = o; }
    LDS_WAIT(); asm volatile("" ::: "memory");
}

template <int MODE>
__device__ __forceinline__ void norm_phase(const Frame& F, const float* gold, const float* gpost, const float* gpre) {
    const int lane = F.lane, c0 = 8 * lane; const int gw = blockIdx.x * NWAVES + F.wave, NGW = F.G * NWAVES;
    const bf16* MBp = (const bf16*)(F.ws + WS_MB); const float* part = (const float*)(F.ws + WS_PART); bf16* HN = (bf16*)(F.ws + WS_HN); float* RINV = (float*)(F.ws + WS_RINV);
    f32x4 gp[4], gn[4], go[4];
#pragma unroll
    for (int j = 0; j < 4; ++j) { const int c = c0 + (j >> 1) * 512 + (j & 1) * 4;
        gp[j] = (MODE != 0) ? *(const f32x4*)(gpost + c) : (f32x4){0.f, 0.f, 0.f, 0.f};
        gn[j] = (MODE != 3) ? *(const f32x4*)(gpre + c) : (f32x4){0.f, 0.f, 0.f, 0.f};
        if (MODE >= 2) { const f32x4 t = *(const f32x4*)(gold + c); go[j] = (f32x4){1.0f / t[0], 1.0f / t[1], 1.0f / t[2], 1.0f / t[3]}; } else go[j] = (f32x4){0.f, 0.f, 0.f, 0.f}; }
    for (int row = gw; row < M; row += NGW) {
        f32x4 x[4];
        if (MODE <= 1) {
            const float* xr = row < MP ? F.in[0] + (size_t)row * D : F.in[1] + (size_t)(row - MP) * D;
#pragma unroll
            for (int j = 0; j < 4; ++j) x[j] = *(const f32x4*)(xr + c0 + (j >> 1) * 512 + (j & 1) * 4);
        } else {
            const bf16* hr = HN + (size_t)row * D; const float ri = RINV[row];
            const u32x4 h0 = *(const u32x4*)(hr + c0), h1 = *(const u32x4*)(hr + 512 + c0);
            x[0] = (f32x4){bflo(h0.x), bfhi(h0.x), bflo(h0.y), bfhi(h0.y)} * ri * go[0];
            x[1] = (f32x4){bflo(h0.z), bfhi(h0.z), bflo(h0.w), bfhi(h0.w)} * ri * go[1];
            x[2] = (f32x4){bflo(h1.x), bfhi(h1.x), bflo(h1.y), bfhi(h1.y)} * ri * go[2];
            x[3] = (f32x4){bflo(h1.z), bfhi(h1.z), bflo(h1.w), bfhi(h1.w)} * ri * go[3];
        }
        if (MODE != 0) {
            const bf16* mr = MBp + (size_t)row * D;
            const u32x4 m0 = *(const u32x4*)(mr + c0), m1 = *(const u32x4*)(mr + 512 + c0);
            const float ps = lane < 16 ? part[(size_t)row * 16 + lane] : 0.f;
            const float rstd = 1.0f / sqrtf(wave_sum(ps) * (1.0f / D) + EPS);
            x[0] += (f32x4){bflo(m0.x), bfhi(m0.x), bflo(m0.y), bfhi(m0.y)} * rstd * gp[0];
            x[1] += (f32x4){bflo(m0.z), bfhi(m0.z), bflo(m0.w), bfhi(m0.w)} * rstd * gp[1];
            x[2] += (f32x4){bflo(m1.x), bfhi(m1.x), bflo(m1.y), bfhi(m1.y)} * rstd * gp[2];
            x[3] += (f32x4){bflo(m1.z), bfhi(m1.z), bflo(m1.w), bfhi(m1.w)} * rstd * gp[3];
        }
        if (MODE == 3) {
            float* orow = F.out + (size_t)row * D;
#pragma unroll
            for (int j = 0; j < 4; ++j) *(f32x4*)(orow + c0 + (j >> 1) * 512 + (j & 1) * 4) = x[j];
        } else {
            float s2 = 0.f;
#pragma unroll
            for (int j = 0; j < 4; ++j) s2 += (x[j][0] * x[j][0] + x[j][1] * x[j][1]) + (x[j][2] * x[j][2] + x[j][3] * x[j][3]);
            const float rinv = sqrtf(wave_sum(s2) * (1.0f / D) + EPS), r2 = 1.0f / rinv;
            if (MODE != 0 && lane == 0) RINV[row] = rinv;
            bf16* hr = HN + (size_t)row * D;
#pragma unroll
            for (int h = 0; h < 2; ++h) { const f32x4 a = x[2 * h] * r2 * gn[2 * h], b = x[2 * h + 1] * r2 * gn[2 * h + 1];
                u32x4 o; o.x = pk2(a[0], a[1]); o.y = pk2(a[2], a[3]); o.z = pk2(b[0], b[1]); o.w = pk2(b[2], b[3]);
                *(u32x4*)(hr + c0 + h * 512) = o; }
        }
    }
}

__device__ __forceinline__ void p0_prologue(const Frame& F) {
    LAS float* scr = (LAS float*)(F.lds + F.wave * 16384);
    const int gw = blockIdx.x * NWAVES + F.wave, NGW = F.G * NWAVES;
    constexpr int I_W1 = 16 * 48, I_SQ = 16 * 32, I_GU = 16 * 88, I_DN = 44 * 32, I_CI = 16 * 96;
    constexpr int NITEMS = I_W1 + I_SQ + 2 * (2 * I_GU + I_DN) + I_CI + I_SQ;
    for (int it = gw; it < NITEMS; it += NGW) {
        int r = it; const float* W; int K, N, mode; size_t off;
        if (r < I_W1) { W = F.in[3]; K = D; N = AB_IN; mode = 0; off = WS_W1; }
        else if ((r -= I_W1) < I_SQ) { W = F.in[9]; K = D; N = D; mode = 0; off = WS_WO0; }
        else if ((r -= I_SQ) < I_GU) { W = F.in[13]; K = D; N = FF; mode = 1; off = WS_WGU0; }
        else if ((r -= I_GU) < I_GU) { W = F.in[14]; K = D; N = FF; mode = 2; off = WS_WGU0; }
        else if ((r -= I_GU) < I_DN) { W = F.in[15]; K = FF; N = D; mode = 0; off = WS_WD0; }
        else if ((r -= I_DN) < I_CI) { W = F.in[10]; K = D; N = CIN; mode = 3; off = WS_WCI; }
        else if ((r -= I_CI) < I_SQ) { W = F.in[12]; K = D; N = D; mode = 0; off = WS_WCO; }
        else if ((r -= I_SQ) < I_GU) { W = F.in[13] + (size_t)D * FF; K = D; N = FF; mode = 1; off = WS_WGU1; }
        else if ((r -= I_GU) < I_GU) { W = F.in[14] + (size_t)D * FF; K = D; N = FF; mode = 2; off = WS_WGU1; }
        else { r -= I_GU; W = F.in[15] + (size_t)D * FF; K = FF; N = D; mode = 0; off = WS_WD1; }
        p0_transpose_item(W, K, N, (bf16*)(F.ws + off), mode, scr, r, F.lane);
    }
    bf16* WSB = (bf16*)(F.ws + WS_WSB); bf16* WPT = (bf16*)(F.ws + WS_WPT);
    for (int i = blockIdx.x * NTHR + F.tid; i < 65536; i += F.G * NTHR) {
        WSB[i] = (bf16)f2bf(F.in[5][i]);
        const int g = i >> 14, d = (i >> 7) & 127, c = i & 127;
        WPT[i] = (bf16)f2bf(F.in[7][(g * 128 + c) * 128 + d]);
    }
    norm_phase<0>(F, nullptr, nullptr, F.in[2]);
}

constexpr int MXS = 272;
__device__ __forceinline__ void mm128(const LAS unsigned char* X, const LAS unsigned char* Y, int w, int fr, int fq, f32x4 (&acc)[8]) {
#pragma unroll
    for (int db = 0; db < 8; ++db) acc[db] = (f32x4){0.f, 0.f, 0.f, 0.f};
#pragma unroll
    for (int ks = 0; ks < 4; ++ks) {
        const bf16x8 yb = *(const LAS bf16x8*)(Y + (16 * w + fr) * MXS + ks * 64 + fq * 16);
#pragma unroll
        for (int db = 0; db < 8; ++db) { const bf16x8 xa = *(const LAS bf16x8*)(X + (db * 16 + fr) * MXS + ks * 64 + fq * 16);
            acc[db] = __builtin_amdgcn_mfma_f32_16x16x32_bf16(xa, yb, acc[db], 0, 0, 0); }
    }
}
__device__ __forceinline__ void mixer_phase(const Frame& F) {
    LAS unsigned char* X = F.lds; LAS unsigned char* Y = F.lds + 128 * MXS; LAS unsigned char* Z = F.lds + 256 * MXS;
    const int tid = F.tid, lane = F.lane, w = F.wave, fr = lane & 15, fq = lane >> 4;
    const bf16* HC = (const bf16*)(F.ws + WS_HC); bf16* AB = (bf16*)(F.ws + WS_HN);
    const bf16* WSB = (const bf16*)(F.ws + WS_WSB); const bf16* WPT = (const bf16*)(F.ws + WS_WPT);
    const float* gv = F.in[4]; const float* bs = F.in[6]; const float* psc = F.in[8];
    for (int idx = blockIdx.x; idx < (M / 128) * 8; idx += F.G) {
        const int chunk = idx >> 3, sub = idx & 7, r0 = chunk * 128;
        if (sub < 4) {
            const int h = sub;
#pragma unroll
            for (int i = 0; i < 4; ++i) { const int pc = tid + i * NTHR, row = pc >> 4, c16 = pc & 15;
                *(LAS u32x4*)(Y + row * MXS + c16 * 16) = *(const u32x4*)(WSB + (h * 128 + row) * 128 + c16 * 8); }
            { const int row = tid >> 2, seg = tid & 3; const bf16* vp = HC + (size_t)(r0 + row) * AB_IN + 512 + h * 128 + seg * 32;
              float v[32];
#pragma unroll
              for (int i = 0; i < 4; ++i) { const u32x4 rw = *(const u32x4*)(vp + 8 * i);
                  v[8 * i + 0] = bflo(rw.x); v[8 * i + 1] = bfhi(rw.x); v[8 * i + 2] = bflo(rw.y); v[8 * i + 3] = bfhi(rw.y);
                  v[8 * i + 4] = bflo(rw.z); v[8 * i + 5] = bfhi(rw.z); v[8 * i + 6] = bflo(rw.w); v[8 * i + 7] = bfhi(rw.w); }
              float s = 0.f;
#pragma unroll
              for (int e = 0; e < 32; ++e) s += v[e];
              s += __shfl_xor(s, 1); s += __shfl_xor(s, 2); const float mu = s * (1.0f / 128.0f);
              float q = 0.f;
#pragma unroll
              for (int e = 0; e < 32; ++e) { v[e] -= mu; q += v[e] * v[e]; }
              q += __shfl_xor(q, 1); q += __shfl_xor(q, 2); const float rstd = 1.0f / sqrtf(q * (1.0f / 128.0f) + EPS);
              const float* gvp = gv + h * 128 + seg * 32;
#pragma unroll
              for (int e4 = 0; e4 < 8; ++e4) { const f32x4 g4 = *(const f32x4*)(gvp + 4 * e4);
#pragma unroll
                  for (int e = 0; e < 4; ++e) { const int d = seg * 32 + 4 * e4 + e;
                      *(LAS unsigned short*)(X + d * MXS + row * 2) = (unsigned short)f2bf(v[4 * e4 + e] * rstd * g4[e]); } }
            }
            __syncthreads();
            f32x4 acc[8]; mm128(X, Y, w, fr, fq, acc);
            const int p = 16 * w + fr; const float bias = bs[h * 128 + p];
            const bf16* up = HC + (size_t)(r0 + p) * AB_IN + h * 128 + fq * 4; bf16* op = AB + (size_t)(r0 + p) * D + h * 128 + fq * 4;
#pragma unroll
            for (int db = 0; db < 8; ++db) { const u32x2 uu = *(const u32x2*)(up + db * 16);
                u32x2 o; o.x = pk2(bflo(uu.x) * (acc[db][0] + bias), bfhi(uu.x) * (acc[db][1] + bias)); o.y = pk2(bflo(uu.y) * (acc[db][2] + bias), bfhi(uu.y) * (acc[db][3] + bias));
                *(u32x2*)(op + db * 16) = o; }
            __syncthreads();
        } else {
            const int gi = sub - 4, hh = 1 << gi; const int pos0 = r0 & (SEQ - 1);
#pragma unroll
            for (int i = 0; i < 4; ++i) { const int pc = tid + i * NTHR, row = pc >> 4, c16 = pc & 15;
                *(LAS u32x4*)(X + row * MXS + c16 * 16) = *(const u32x4*)(WPT + (gi * 128 + row) * 128 + c16 * 8); }
            for (int pc = tid; pc < 144 * 16; pc += NTHR) { const int zr = pc >> 4, c16 = pc & 15, pos = pos0 + zr - 8;
                u32x4 val = (u32x4){0u, 0u, 0u, 0u};
                if (pos >= 0 && pos < SEQ) val = *(const u32x4*)(HC + (size_t)(r0 + zr - 8) * AB_IN + 1024 + gi * 128 + c16 * 8);
                *(LAS u32x4*)(Z + zr * MXS + c16 * 16) = val; }
            __syncthreads();
            { const int i = tid >> 2, seg = tid & 3, pos = pos0 + i;
              const int hi = (pos + hh < SEQ) ? pos + hh : SEQ, lo = (pos - hh > 0) ? pos - hh : 0; const float inv = 1.0f / (float)(hi - lo);
#pragma unroll
              for (int gq = 0; gq < 4; ++gq) { const int cb = (seg * 32 + gq * 8) * 2;
                  float s[8];
#pragma unroll
                  for (int e = 0; e < 8; ++e) s[e] = 0.f;
                  for (int j = -hh; j < hh; ++j) { const u32x4 rw = *(const LAS u32x4*)(Z + (i + 8 + j) * MXS + cb);
                      s[0] += bflo(rw.x); s[1] += bfhi(rw.x); s[2] += bflo(rw.y); s[3] += bfhi(rw.y); s[4] += bflo(rw.z); s[5] += bfhi(rw.z); s[6] += bflo(rw.w); s[7] += bfhi(rw.w); }
                  const u32x4 zc = *(const LAS u32x4*)(Z + (i + 8) * MXS + cb);
                  u32x4 o; o.x = pk2(s[0] * inv - bflo(zc.x), s[1] * inv - bfhi(zc.x)); o.y = pk2(s[2] * inv - bflo(zc.y), s[3] * inv - bfhi(zc.y));
                  o.z = pk2(s[4] * inv - bflo(zc.z), s[5] * inv - bfhi(zc.z)); o.w = pk2(s[6] * inv - bflo(zc.w), s[7] * inv - bfhi(zc.w));
                  *(LAS u32x4*)(Y + i * MXS + cb) = o; }
            }
            __syncthreads();
            f32x4 acc[8]; mm128(X, Y, w, fr, fq, acc);
            const int i = 16 * w + fr; const float* pp = psc + gi * 128 + fq * 4; bf16* op = AB + (size_t)(r0 + i) * D + 512 + gi * 128 + fq * 4;
#pragma unroll
            for (int db = 0; db < 8; ++db) { const f32x4 sc = *(const f32x4*)(pp + db * 16); const f32x4 r = acc[db] * sc;
                u32x2 o; o.x = pk2(r[0], r[1]); o.y = pk2(r[2], r[3]); *(u32x2*)(op + db * 16) = o; }
            __syncthreads();
        }
    }
}

__device__ __forceinline__ void conv_phase(const Frame& F) {
    const bf16* T = (const bf16*)(F.ws + WS_T); const bf16* GB = (const bf16*)(F.ws + WS_GB); bf16* CV = (bf16*)(F.ws + WS_GB);
    const float* cw = F.in[11];
    for (int item = blockIdx.x * NTHR + F.tid; item < M * 128; item += F.G * NTHR) {
        const int row = item >> 7, c8 = (item & 127) * 8, pos = row & (SEQ - 1);
        const size_t o = (size_t)row * D + c8;
        const u32x4 z4 = (u32x4){0u, 0u, 0u, 0u};
        const u32x4 t1 = *(const u32x4*)(T + o), t0 = pos > 0 ? *(const u32x4*)(T + o - D) : z4, t2 = pos < SEQ - 1 ? *(const u32x4*)(T + o + D) : z4, gb = *(const u32x4*)(GB + o);
        const f32x4 w0a = *(const f32x4*)(cw + c8), w0b = *(const f32x4*)(cw + c8 + 4), w1a = *(const f32x4*)(cw + D + c8), w1b = *(const f32x4*)(cw + D + c8 + 4),
                    w2a = *(const f32x4*)(cw + 2 * D + c8), w2b = *(const f32x4*)(cw + 2 * D + c8 + 4);
        const f32x4 a0 = (f32x4){bflo(t0.x), bfhi(t0.x), bflo(t0.y), bfhi(t0.y)}, b0 = (f32x4){bflo(t0.z), bfhi(t0.z), bflo(t0.w), bfhi(t0.w)};
        const f32x4 a1 = (f32x4){bflo(t1.x), bfhi(t1.x), bflo(t1.y), bfhi(t1.y)}, b1 = (f32x4){bflo(t1.z), bfhi(t1.z), bflo(t1.w), bfhi(t1.w)};
        const f32x4 a2 = (f32x4){bflo(t2.x), bfhi(t2.x), bflo(t2.y), bfhi(t2.y)}, b2 = (f32x4){bflo(t2.z), bfhi(t2.z), bflo(t2.w), bfhi(t2.w)};
        const f32x4 ga = (f32x4){bflo(gb.x), bfhi(gb.x), bflo(gb.y), bfhi(gb.y)}, gbb = (f32x4){bflo(gb.z), bfhi(gb.z), bflo(gb.w), bfhi(gb.w)};
        const f32x4 ra = ga * (a0 * w0a + a1 * w1a + a2 * w2a), rb = gbb * (b0 * w0b + b1 * w1b + b2 * w2b);
        u32x4 ov; ov.x = pk2(ra[0], ra[1]); ov.y = pk2(ra[2], ra[3]); ov.z = pk2(rb[0], rb[1]); ov.w = pk2(rb[2], rb[3]);
        *(u32x4*)(CV + o) = ov;
    }
}

struct Args { const float* in[16]; float* out; unsigned char* ws; };
__global__ void __launch_bounds__(NTHR, 2) mk_fwd(Args args) {
    extern __shared__ __attribute__((aligned(16))) unsigned char lds_raw[];
    cg::grid_group grid = cg::this_grid();
    Frame F;
    F.lds = (LAS unsigned char*)lds_raw;
    F.tid = threadIdx.x; F.lane = F.tid & 63; F.wave = __builtin_amdgcn_readfirstlane(F.tid >> 6); F.G = gridDim.x;
#pragma unroll
    for (int i = 0; i < 16; ++i) F.in[i] = args.in[i];
    F.out = args.out; F.ws = args.ws;
    unsigned char* ws = args.ws;
    bf16* HN = (bf16*)(ws + WS_HN); bf16* MB = (bf16*)(ws + WS_MB); bf16* HF = (bf16*)(ws + WS_HF); float* PART = (float*)(ws + WS_PART);
    const float* ng = F.in[2];
    const int bid = (int)blockIdx.x;

    volatile LAS unsigned* bst = (volatile LAS unsigned*)(F.lds + LDS_BYTES - 64);
    if (F.tid < 16) bst[F.tid] = 0u;
    unsigned* barw = (unsigned*)ws;
    if (bid == 0) for (int i = F.tid; i < XCD_BAR_WORDS; i += NTHR) __hip_atomic_store(barw + i, 0u, __ATOMIC_RELAXED, __HIP_MEMORY_SCOPE_AGENT);
    p0_prologue(F);
    grid.sync();
    const XcdBarrier xbar = xcd_barrier_post(barw, bst);
#define GRID_BAR() xcd_barrier(xbar)
    { pg8::Gemm g{HN, (const bf16*)(ws + WS_W1), M, AB_IN, D}; pg8::StaticOrder S; S.init(M, AB_IN, F.G, bid);
      pg8::EpiAct E{(bf16*)(ws + WS_HC), AB_IN, 4};
      pg8::gemm_phase<pg8::EpiAct, pg8::StaticOrder, true, true>(F.lds, g, S, E); }
    GRID_BAR();
    mixer_phase(F);
    GRID_BAR();
    { pg8::Gemm g{HN, (const bf16*)(ws + WS_WO0), M, D, D}; pg8::StaticOrder S; S.init(M, D, F.G, bid);
      pg8::EpiStats E{MB, PART};
      pg8::gemm_phase<pg8::EpiStats, pg8::StaticOrder, true, true>(F.lds, g, S, E); }
    GRID_BAR();
    norm_phase<1>(F, nullptr, ng + 1 * D, ng + 2 * D);
    GRID_BAR();
    { pg8::Gemm g{HN, (const bf16*)(ws + WS_WGU0), M, 2 * FF, D}; pg8::StaticOrder S; S.init(M, 2 * FF, F.G, bid);
      pg8::EpiSwiglu E{HF, FF, false};
      pg8::gemm_phase<pg8::EpiSwiglu, pg8::StaticOrder, true, true>(F.lds, g, S, E); }
    GRID_BAR();
#ifdef PROBE_P5
    { pg8::Gemm g{HN, (const bf16*)(ws + WS_WGU0), M, 2 * FF, D}; pg8::StaticOrder S; S.init(M, 2 * FF, F.G, bid);
      pg8::EpiSwiglu E{HF, FF, (PROBE_P5 == 2) && (args.out != nullptr)};
      pg8::gemm_phase<pg8::EpiSwiglu, pg8::StaticOrder, true, true>(F.lds, g, S, E); }
    GRID_BAR();
#endif
    { pg8::Gemm g{HF, (const bf16*)(ws + WS_WD0), M, D, FF}; pg8::StaticOrder S; S.init(M, D, F.G, bid);
      pg8::EpiStats E{MB, PART};
      pg8::gemm_phase<pg8::EpiStats, pg8::StaticOrder, true, true>(F.lds, g, S, E); }
    GRID_BAR();
    norm_phase<2>(F, ng + 2 * D, ng + 3 * D, ng + 4 * D);
    GRID_BAR();
    { pg8::Gemm g{HN, (const bf16*)(ws + WS_WCI), M, CIN, D}; pg8::StaticOrder S; S.init(M, CIN, F.G, bid);
      pg8::EpiMulSplit E{(bf16*)(ws + WS_T), (bf16*)(ws + WS_GB)};
      pg8::gemm_phase<pg8::EpiMulSplit, pg8::StaticOrder, true, true>(F.lds, g, S, E); }
    GRID_BAR();
    conv_phase(F);
    GRID_BAR();
    { pg8::Gemm g{(const bf16*)(ws + WS_GB), (const bf16*)(ws + WS_WCO), M, D, D}; pg8::StaticOrder S; S.init(M, D, F.G, bid);
      pg8::EpiStats E{MB, PART};
      pg8::gemm_phase<pg8::EpiStats, pg8::StaticOrder, true, true>(F.lds, g, S, E); }
    GRID_BAR();
    norm_phase<2>(F, ng + 4 * D, ng + 5 * D, ng + 6 * D);
    GRID_BAR();
    { pg8::Gemm g{HN, (const bf16*)(ws + WS_WGU1), M, 2 * FF, D}; pg8::StaticOrder S; S.init(M, 2 * FF, F.G, bid);
      pg8::EpiSwiglu E{HF, FF, false};
      pg8::gemm_phase<pg8::EpiSwiglu, pg8::StaticOrder, true, true>(F.lds, g, S, E); }
    GRID_BAR();
    { pg8::Gemm g{HF, (const bf16*)(ws + WS_WD1), M, D, FF}; pg8::StaticOrder S; S.init(M, D, F.G, bid);
      pg8::EpiStats E{MB, PART};
      pg8::gemm_phase<pg8::EpiStats, pg8::StaticOrder, true, true>(F.lds, g, S, E); }
    GRID_BAR();
    norm_phase<3>(F, ng + 6 * D, ng + 7 * D, nullptr);
}

extern "C" void kernel_launch(void* const* d_in, const int* in_sizes, int n_in, void* d_out, int out_size, void* d_ws, size_t ws_size, hipStream_t stream) {
    static int grid = 0;
    if (grid == 0) {
        if (n_in != 16 || out_size != M * D || ws_size < WS_END) { fprintf(stderr, "kernel_launch: unexpected shapes (n_in %d, out %d, ws %zu); nothing launched\n", n_in, out_size, ws_size); grid = -1; return; }
        int dev = 0, cus = 0, per_cu = 0;
        if (hipGetDevice(&dev) != hipSuccess || hipDeviceGetAttribute(&cus, hipDeviceAttributeMultiprocessorCount, dev) != hipSuccess) { grid = -1; return; }
        if (hipFuncSetAttribute((const void*)mk_fwd, hipFuncAttributeMaxDynamicSharedMemorySize, LDS_BYTES) != hipSuccess) { fprintf(stderr, "kernel_launch: hipFuncSetAttribute failed\n"); grid = -1; return; }
        if (hipOccupancyMaxActiveBlocksPerMultiprocessor(&per_cu, (const void*)mk_fwd, NTHR, LDS_BYTES) != hipSuccess || per_cu < 1) { fprintf(stderr, "kernel_launch: occupancy query says %d\n", per_cu); per_cu = 1; }
        (void)hipGetLastError();
        grid = cus;
    }
    if (grid < 0) return;
    Args a{};
    for (int i = 0; i < 16; ++i) a.in[i] = (const float*)d_in[i];
    a.out = (float*)d_out; a.ws = (unsigned char*)d_ws;
    void* kargs[] = {&a};
    hipError_t e = hipLaunchCooperativeKernel((const void*)mk_fwd, dim3(grid), dim3(NTHR), kargs, LDS_BYTES, stream);
    if (e != hipSuccess) fprintf(stderr, "kernel_launch: cooperative launch failed: %s (grid %d)\n", hipGetErrorString(e), grid);
}
```

```cpp
#include <hip/hip_runtime.h>
#include <hip/hip_cooperative_groups.h>
#include <cstdio>
#include <cstdint>
namespace cg = cooperative_groups;

namespace pg8 {
#define PG8_LAS __attribute__((address_space(3)))
typedef unsigned short bf16_t;
typedef short bf16x8 __attribute__((ext_vector_type(8)));
typedef float f32x4 __attribute__((ext_vector_type(4)));
typedef unsigned u32x4 __attribute__((ext_vector_type(4)));
typedef unsigned u32x2 __attribute__((ext_vector_type(2)));
constexpr int BM = 256, BK = 64, HALF = 128, HTB = HALF * BK * 2  , STAGE_BYTES = 8 * HTB, NXCD = 8, WGM = 8;

__host__ __device__ __forceinline__ int lds_byte(int r, int c) { const int st = (r >> 4) * 2 + (c >> 5), rr = r & 15, cc = c & 31, ob = rr * 64 + cc * 2; return st * 1024 + (ob ^ (((ob >> 9) & 1) << 5)); }
__host__ __device__ __forceinline__ void stage_rc(int b, int& R, int& C) { const int st = b / 1024, sb = b % 1024, swz = sb ^ (((sb >> 9) & 1) << 5); R = (st >> 1) * 16 + swz / 64; C = (st & 1) * 32 + (swz % 64) / 2; }
__host__ __device__ __forceinline__ int perm32(int rho) { const int n = rho >> 4, i = rho & 15; return 8 * (i >> 2) + 4 * n + (i & 3); }

struct Unit { int pm, pn; };
struct Gemm { const bf16_t* A; const bf16_t* Bt; int M, N, K; };

struct StaticOrder {
    int nM, nN, nwg, G, c;
    __host__ __device__ void init(int M, int N, int G_, int c_) { nM = M / BM; nN = N / BM; nwg = nM * nN; G = G_; c = c_; }
    __host__ __device__ bool next(int i, Unit& u) const {
        const long L = (long)i * G + c; if (L >= nwg) return false;
        int wgid = (int)L; { const int q = nwg / NXCD, r = nwg % NXCD, xcd = wgid % NXCD, off = wgid / NXCD; wgid = (xcd < r ? xcd * (q + 1) : r * (q + 1) + (xcd - r) * q) + off; }
        const int nig = WGM * nN, gid = wgid / nig, fm = gid * WGM, gsz = (nM - fm) < WGM ? (nM - fm) : WGM;
        u.pm = fm + ((wgid % nig) % gsz); u.pn = (wgid % nig) / gsz; return true;
    }
    __device__ __forceinline__ void a_ready(const Unit&) const {}
    __device__ __forceinline__ void done(const Unit&) const {}
};

__device__ __forceinline__ unsigned cvt_pk_bf16(float lo, float hi) { unsigned r; asm volatile("v_cvt_pk_bf16_f32 %0, %1, %2" : "=v"(r) : "v"(lo), "v"(hi)); return r; }
__device__ __forceinline__ u32x4 pack8(const f32x4 v0, const f32x4 v1) { u32x4 w; w.x = cvt_pk_bf16(v0[0], v0[1]); w.y = cvt_pk_bf16(v0[2], v0[3]); w.z = cvt_pk_bf16(v1[0], v1[1]); w.w = cvt_pk_bf16(v1[2], v1[3]); return w; }
__device__ __forceinline__ float gelu_tanh(float x) { const float t = x * (1.0f + 0.044715f * x * x) * (-2.302208198f); return x * __builtin_amdgcn_rcpf(1.0f + __builtin_amdgcn_exp2f(t)); }
__device__ __forceinline__ float silu_f(float x) { return x * __builtin_amdgcn_rcpf(1.0f + __builtin_amdgcn_exp2f(x * (-1.4426950409f))); }
__device__ __forceinline__ f32x4 gelu4(const f32x4 v) { return (f32x4){gelu_tanh(v[0]), gelu_tanh(v[1]), gelu_tanh(v[2]), gelu_tanh(v[3])}; }
__device__ __forceinline__ f32x4 silu4(const f32x4 v) { return (f32x4){silu_f(v[0]), silu_f(v[1]), silu_f(v[2]), silu_f(v[3])}; }

struct EpiAct {
    static constexpr bool PERM = true, AFTER_DRAIN = false;
    bf16_t* O; int ldc; int n_act;
    __device__ __forceinline__ void operator()(const f32x4 (&acc)[2][2][4][2], const Unit& u, int wr, int wc, int fr, int fq) const {
        const int row0 = u.pm * BM + wr * 64 + fr, col0 = u.pn * BM + wc * 32 + 8 * fq; const bool act = u.pn < n_act;
#pragma unroll
        for (int ai = 0; ai < 2; ++ai)
#pragma unroll
            for (int m = 0; m < 4; ++m) { bf16_t* rowp = O + (size_t)(row0 + ai * HALF + m * 16) * ldc + col0;
#pragma unroll
                for (int bj = 0; bj < 2; ++bj) { f32x4 v0 = acc[ai][bj][m][0], v1 = acc[ai][bj][m][1];
                    if (act) { v0 = gelu4(v0); v1 = gelu4(v1); }
                    *(u32x4*)(rowp + bj * HALF) = pack8(v0, v1); } }
    }
};
struct EpiStats {
    static constexpr bool PERM = true, AFTER_DRAIN = false;
    bf16_t* O; float* part;
    __device__ __forceinline__ void operator()(const f32x4 (&acc)[2][2][4][2], const Unit& u, int wr, int wc, int fr, int fq) const {
        const int row0 = u.pm * BM + wr * 64 + fr, col0 = u.pn * BM + wc * 32 + 8 * fq;
#pragma unroll
        for (int ai = 0; ai < 2; ++ai)
#pragma unroll
            for (int m = 0; m < 4; ++m) { const int row = row0 + ai * HALF + m * 16; bf16_t* rowp = O + (size_t)row * 1024 + col0; float s = 0.f;
#pragma unroll
                for (int bj = 0; bj < 2; ++bj) { const f32x4 v0 = acc[ai][bj][m][0], v1 = acc[ai][bj][m][1];
                    s += (v0[0] * v0[0] + v0[1] * v0[1]) + (v0[2] * v0[2] + v0[3] * v0[3]) + (v1[0] * v1[0] + v1[1] * v1[1]) + (v1[2] * v1[2] + v1[3] * v1[3]);
                    *(u32x4*)(rowp + bj * HALF) = pack8(v0, v1); }
                s += __shfl_xor(s, 16); s += __shfl_xor(s, 32);
                if (fq == 0) part[(size_t)row * 16 + u.pn * 4 + wc] = s; }
    }
};
struct EpiSwiglu {
    static constexpr bool PERM = true, AFTER_DRAIN = false;
    bf16_t* O; int ldc;
    __device__ __forceinline__ void operator()(const f32x4 (&acc)[2][2][4][2], const Unit& u, int wr, int wc, int fr, int fq) const {
        const int row0 = u.pm * BM + wr * 64 + fr, col0 = u.pn * HALF + wc * 32 + 8 * fq;
#pragma unroll
        for (int ai = 0; ai < 2; ++ai)
#pragma unroll
            for (int m = 0; m < 4; ++m) { bf16_t* rowp = O + (size_t)(row0 + ai * HALF + m * 16) * ldc + col0;
                const f32x4 v0 = silu4(acc[ai][0][m][0]) * acc[ai][1][m][0], v1 = silu4(acc[ai][0][m][1]) * acc[ai][1][m][1];
                *(u32x4*)rowp = pack8(v0, v1); }
    }
};
struct EpiMulSplit {
    static constexpr bool PERM = true, AFTER_DRAIN = false;
    bf16_t* T; bf16_t* GB;
    __device__ __forceinline__ void operator()(const f32x4 (&acc)[2][2][4][2], const Unit& u, int wr, int wc, int fr, int fq) const {
        const int row0 = u.pm * BM + wr * 64 + fr;
        if (u.pn < 8) { const int col0 = u.pn * HALF + wc * 32 + 8 * fq;
#pragma unroll
            for (int ai = 0; ai < 2; ++ai)
#pragma unroll
                for (int m = 0; m < 4; ++m) { bf16_t* rowp = T + (size_t)(row0 + ai * HALF + m * 16) * 1024 + col0;
                    *(u32x4*)rowp = pack8(acc[ai][0][m][0] * acc[ai][1][m][0], acc[ai][0][m][1] * acc[ai][1][m][1]); }
        } else { const int col0 = (u.pn - 8) * BM + wc * 32 + 8 * fq;
#pragma unroll
            for (int ai = 0; ai < 2; ++ai)
#pragma unroll
                for (int m = 0; m < 4; ++m) { bf16_t* rowp = GB + (size_t)(row0 + ai * HALF + m * 16) * 1024 + col0;
#pragma unroll
                    for (int bj = 0; bj < 2; ++bj) *(u32x4*)(rowp + bj * HALF) = pack8(acc[ai][bj][m][0], acc[ai][bj][m][1]); }
        }
    }
};

template <class Epi, class Sched, bool ALIGN_EPI = false, bool SP2 = false>
__device__ __forceinline__ void gemm_phase(PG8_LAS unsigned char* lds, const Gemm g, const Sched& S, const Epi& E) {
    const int tid = threadIdx.x, wid = __builtin_amdgcn_readfirstlane(tid >> 6), lane = tid & 63, wr = wid >> 2, wc = wid & 3, fr = lane & 15, fq = lane >> 4;
    const int K = g.K, nt = K / BK;
    unsigned voffA[2], voffB[2];
#pragma unroll
    for (int i = 0; i < 2; ++i) { int R, C; stage_rc(tid * 16 + i * 8192, R, C); const int Rb = Epi::PERM ? ((R & ~31) + perm32(R & 31)) : R;
        voffA[i] = (unsigned)(R * K + C) * 2u; voffB[i] = (unsigned)(Rb * K + C) * 2u; }
    const size_t kstep = (size_t)(BK * 2);
    const size_t hstep = (size_t)HALF * K * 2;
    const size_t tstep = 2 * hstep;
    const unsigned ldsw = (unsigned)wid * 1024u;
    const int aoff = lds_byte(wr * 64 + fr, fq * 8), boff = lds_byte(wc * 32 + fr, fq * 8);
#define PG8_SA(b, h) (((b) * 2 + (h)) * HTB)
#define PG8_SB(b, h) ((4 + (b) * 2 + (h)) * HTB)
#define PG8_STAGE(bufoff, gbase, voff) do { _Pragma("unroll") for (int _i = 0; _i < 2; ++_i) \
        __builtin_amdgcn_global_load_lds((const unsigned*)((const char*)(gbase) + (voff)[_i]), (PG8_LAS unsigned*)(lds + (bufoff) + ldsw + _i * 8192), 16, 0, 0); } while (0)
#define PG8_LDA(dst, b, h) do { _Pragma("unroll") for (int m = 0; m < 4; ++m) _Pragma("unroll") for (int k = 0; k < 2; ++k) dst[m][k] = *(const PG8_LAS bf16x8*)(lds + PG8_SA(b, h) + aoff + m * 2048 + k * 1024); } while (0)
#define PG8_LDB(dst, b, h) do { _Pragma("unroll") for (int n = 0; n < 2; ++n) _Pragma("unroll") for (int k = 0; k < 2; ++k) dst[n][k] = *(const PG8_LAS bf16x8*)(lds + PG8_SB(b, h) + boff + n * 2048 + k * 1024); } while (0)
#define PG8_MMA(ai, bj, At, Bt) do { __builtin_amdgcn_s_setprio(1); _Pragma("unroll") for (int m = 0; m < 4; ++m) _Pragma("unroll") for (int n = 0; n < 2; ++n) _Pragma("unroll") for (int k = 0; k < 2; ++k) \
        acc[ai][bj][m][n] = __builtin_amdgcn_mfma_f32_16x16x32_bf16(Bt[n][k], At[m][k], acc[ai][bj][m][n], 0, 0, 0); __builtin_amdgcn_s_setprio(0); } while (0)
#define PG8_WAIT_V(n) asm volatile("s_waitcnt vmcnt(" #n ")" ::: "memory")
#define PG8_WAIT_L(n) asm volatile("s_waitcnt lgkmcnt(" #n ")" ::: "memory")
#define PG8_BAR __builtin_amdgcn_s_barrier()
#define PG8_SCHED __builtin_amdgcn_sched_barrier(0)
    Unit cur, nxt; int ui = 0;
    if (!S.next(0, cur)) return;
    f32x4 acc[2][2][4][2];
#pragma unroll
    for (int a = 0; a < 2; ++a)
#pragma unroll
        for (int b = 0; b < 2; ++b)
#pragma unroll
            for (int m = 0; m < 4; ++m)
#pragma unroll
                for (int n = 0; n < 2; ++n) acc[a][b][m][n] = (f32x4){0.f, 0.f, 0.f, 0.f};
    bf16x8 At[4][2], B0[2][2], B1[2][2];
    const char* cA = (const char*)g.A + (size_t)cur.pm * tstep; const char* cB = (const char*)g.Bt + (size_t)cur.pn * tstep;
    S.a_ready(cur);
    if constexpr (SP2) {
        PG8_STAGE(PG8_SB(0, 0), cB, voffB); PG8_STAGE(PG8_SB(0, 1), cB + hstep, voffB); PG8_STAGE(PG8_SA(0, 0), cA, voffA); PG8_STAGE(PG8_SA(0, 1), cA + hstep, voffA);
        if (wr == 1) PG8_BAR;
        PG8_WAIT_V(2); PG8_BAR;
        PG8_STAGE(PG8_SB(1, 0), cB + kstep, voffB); PG8_STAGE(PG8_SA(1, 0), cA + kstep, voffA); PG8_STAGE(PG8_SB(1, 1), cB + hstep + kstep, voffB);
        PG8_WAIT_V(6); PG8_BAR;
    } else {
        PG8_STAGE(PG8_SB(0, 0), cB, voffB); PG8_STAGE(PG8_SA(0, 0), cA, voffA); PG8_STAGE(PG8_SB(0, 1), cB + hstep, voffB); PG8_STAGE(PG8_SA(0, 1), cA + hstep, voffA);
        if (wr == 1) PG8_BAR;
        PG8_WAIT_V(4); PG8_BAR;
        PG8_STAGE(PG8_SB(1, 0), cB + kstep, voffB); PG8_STAGE(PG8_SA(1, 0), cA + kstep, voffA); PG8_STAGE(PG8_SB(1, 1), cB + hstep + kstep, voffB);
        PG8_WAIT_V(6); PG8_BAR;
    }
    for (;;) {
        const bool has_next = S.next(ui + 1, nxt);
        const char* nA = has_next ? (const char*)g.A + (size_t)nxt.pm * tstep : cA; const char* nB = has_next ? (const char*)g.Bt + (size_t)nxt.pn * tstep : cB;
        for (int t = 0; t < nt; t += 2) {
            const bool last = (t == nt - 2);
            const char* a1 = cA + (size_t)(t + 1) * kstep;
            const char* a2 = last ? nA : cA + (size_t)(t + 2) * kstep; const char* b2 = last ? nB : cB + (size_t)(t + 2) * kstep;
            const char* a3 = a2 + kstep; const char* b3 = b2 + kstep;
            if (last && has_next) S.a_ready(nxt);
            if constexpr (SP2) {
            PG8_LDB(B0, 0, 0); PG8_LDB(B1, 0, 1); PG8_SCHED; PG8_LDA(At, 0, 0); PG8_STAGE(PG8_SA(1, 1), a1 + hstep, voffA);
            PG8_WAIT_V(8); PG8_WAIT_L(0); PG8_BAR; PG8_MMA(0, 0, At, B0); PG8_MMA(0, 1, At, B1); PG8_BAR; PG8_SCHED;
            PG8_LDA(At, 0, 1); PG8_STAGE(PG8_SB(0, 0), b2, voffB); PG8_STAGE(PG8_SB(0, 1), b2 + hstep, voffB); PG8_STAGE(PG8_SA(0, 0), a2, voffA);
            PG8_WAIT_V(8); PG8_WAIT_L(0); PG8_BAR; PG8_MMA(1, 0, At, B0); PG8_MMA(1, 1, At, B1); PG8_BAR; PG8_SCHED;
            PG8_LDB(B0, 1, 0); PG8_LDB(B1, 1, 1); PG8_SCHED; PG8_LDA(At, 1, 0); PG8_STAGE(PG8_SA(0, 1), a2 + hstep, voffA);
            PG8_WAIT_V(8); PG8_WAIT_L(0); PG8_BAR; PG8_MMA(0, 0, At, B0); PG8_MMA(0, 1, At, B1); PG8_BAR; PG8_SCHED;
            PG8_LDA(At, 1, 1); PG8_STAGE(PG8_SB(1, 0), b3, voffB); PG8_STAGE(PG8_SB(1, 1), b3 + hstep, voffB); PG8_STAGE(PG8_SA(1, 0), a3, voffA);
            PG8_WAIT_V(8); PG8_WAIT_L(0); PG8_BAR; PG8_MMA(1, 0, At, B0); PG8_MMA(1, 1, At, B1); PG8_BAR; PG8_SCHED;
            } else {
            PG8_LDB(B0, 0, 0); PG8_SCHED; PG8_LDA(At, 0, 0); PG8_STAGE(PG8_SA(1, 1), a1 + hstep, voffA);
            PG8_WAIT_L(8); PG8_BAR; PG8_WAIT_L(0); PG8_MMA(0, 0, At, B0); PG8_BAR; PG8_SCHED;
            PG8_LDB(B1, 0, 1); PG8_STAGE(PG8_SB(0, 0), b2, voffB);
            PG8_BAR; PG8_WAIT_L(0); PG8_MMA(0, 1, At, B1); PG8_BAR;
            PG8_LDA(At, 0, 1); PG8_STAGE(PG8_SA(0, 0), a2, voffA);
            PG8_BAR; PG8_WAIT_L(0); PG8_MMA(1, 0, At, B0); PG8_BAR; PG8_SCHED;
            PG8_STAGE(PG8_SB(0, 1), b2 + hstep, voffB);
            PG8_WAIT_V(6); PG8_BAR; PG8_MMA(1, 1, At, B1); PG8_BAR;
            PG8_LDB(B0, 1, 0); PG8_SCHED; PG8_LDA(At, 1, 0); PG8_STAGE(PG8_SA(0, 1), a2 + hstep, voffA);
            PG8_WAIT_L(8); PG8_BAR; PG8_WAIT_L(0); PG8_MMA(0, 0, At, B0); PG8_BAR; PG8_SCHED;
            PG8_LDB(B1, 1, 1); PG8_STAGE(PG8_SB(1, 0), b3, voffB);
            PG8_BAR; PG8_WAIT_L(0); PG8_MMA(0, 1, At, B1); PG8_BAR;
            PG8_LDA(At, 1, 1); PG8_STAGE(PG8_SA(1, 0), a3, voffA);
            PG8_BAR; PG8_WAIT_L(0); PG8_MMA(1, 0, At, B0); PG8_BAR; PG8_SCHED;
            PG8_STAGE(PG8_SB(1, 1), b3 + hstep, voffB);
            PG8_WAIT_V(6); PG8_BAR; PG8_MMA(1, 1, At, B1); PG8_BAR;
            }
        }
        if constexpr (ALIGN_EPI) { if (wr == 0) PG8_BAR; }
        if constexpr (!Epi::AFTER_DRAIN) { E(acc, cur, wr, wc, fr, fq); S.done(cur); }
        if (!has_next) break;
#pragma unroll
        for (int a = 0; a < 2; ++a)
#pragma unroll
            for (int b = 0; b < 2; ++b)
#pragma unroll
                for (int m = 0; m < 4; ++m)
#pragma unroll
                    for (int n = 0; n < 2; ++n) acc[a][b][m][n] = (f32x4){0.f, 0.f, 0.f, 0.f};
        cur = nxt; cA = nA; cB = nB; ++ui;
        if constexpr (ALIGN_EPI) { if (wr == 1) PG8_BAR; }
    }
    PG8_WAIT_V(0);
    if constexpr (!ALIGN_EPI) { if (wr == 0) PG8_BAR; }
    PG8_BAR;
#undef PG8_SA
#undef PG8_SB
#undef PG8_STAGE
#undef PG8_LDA
#undef PG8_LDB
#undef PG8_MMA
#undef PG8_WAIT_V
#undef PG8_WAIT_L
#undef PG8_BAR
#undef PG8_SCHED
}
}

constexpr int D = 1024, SEQ = 4096, MP = 8 * SEQ, MS = 4 * SEQ, M = MP + MS;
constexpr int AB_IN = 1536, FF = 2816, CIN = 3072;
constexpr float EPS = 1e-6f;
constexpr int NWAVES = 8, NTHR = 512;

constexpr size_t MiB = 1u << 20;
constexpr size_t WS_WSB = 1 * MiB, WS_WPT = 1 * MiB + 128 * 1024;
constexpr size_t WS_W1 = 2 * MiB, WS_WO0 = 5 * MiB, WS_WGU0 = 7 * MiB, WS_WD0 = 18 * MiB, WS_WCI = 24 * MiB, WS_WCO = 30 * MiB, WS_WGU1 = 32 * MiB, WS_WD1 = 43 * MiB;
constexpr size_t WS_RINV = 48 * MiB + 512 * 1024;
constexpr size_t WS_PART = 49 * MiB;
constexpr size_t WS_HF = 52 * MiB;
constexpr size_t WS_HC = WS_HF, WS_T = WS_HF, WS_GB = WS_HF + 96 * MiB, WS_AB = WS_HF + 144 * MiB;
constexpr size_t WS_HN = 316 * MiB;
constexpr size_t WS_MB = 412 * MiB;
constexpr size_t WS_END = 508 * MiB;
static_assert(WS_WD1 + (size_t)D * FF * 2 <= WS_RINV && WS_RINV + (size_t)M * 4 <= WS_PART && WS_PART + (size_t)M * 64 <= WS_HF && WS_HF + (size_t)M * FF * 2 <= WS_HN && WS_HN + (size_t)M * D * 2 <= WS_MB && WS_MB + (size_t)M * D * 2 <= WS_END, "d_ws map");
static_assert(WS_HC + (size_t)M * AB_IN * 2 <= WS_AB && WS_AB + (size_t)M * D * 2 <= WS_HN && WS_GB + (size_t)M * D * 2 <= WS_HN, "overlay map");

constexpr int LDS_BYTES = 147456;

#define LAS __attribute__((address_space(3)))
typedef unsigned short bf16;
typedef float f32x4 __attribute__((ext_vector_type(4)));
typedef unsigned u32x4 __attribute__((ext_vector_type(4)));
typedef unsigned u32x2 __attribute__((ext_vector_type(2)));
typedef short bf16x8 __attribute__((ext_vector_type(8)));
#define LDS_WAIT() asm volatile("s_waitcnt lgkmcnt(0)" ::: "memory")
__device__ __forceinline__ unsigned f2bf(float f) { unsigned u = __builtin_bit_cast(unsigned, f); return (u + 0x7fffu + ((u >> 16) & 1u)) >> 16; }
__device__ __forceinline__ unsigned pk2(float lo, float hi) { unsigned r; asm("v_cvt_pk_bf16_f32 %0, %1, %2" : "=v"(r) : "v"(lo), "v"(hi)); return r; }
__device__ __forceinline__ float bflo(unsigned u) { return __uint_as_float(u << 16); }
__device__ __forceinline__ float bfhi(unsigned u) { return __uint_as_float(u & 0xffff0000u); }
__device__ __forceinline__ float wave_sum(float v) {
#pragma unroll
    for (int o = 1; o < 64; o <<= 1) v += __shfl_xor(v, o);
    return v;
}


#define XB_TMO      128
#define XB_XCNT(j)  (256  + 64 * (j))
#define XB_XSUB(j)  (1280 + 64 * (j))
#define XB_XGEN(j)  (2304 + 64 * (j))
#define XB_TOP      3328
#define XB_TOPGEN   3392
#define XCD_BAR_WORDS 3456
#define XB_SPIN_CAP (1u << 18)
__device__ __forceinline__ unsigned xb_ld(unsigned* p)              { return __hip_atomic_load(p, __ATOMIC_RELAXED, __HIP_MEMORY_SCOPE_AGENT); }
__device__ __forceinline__ unsigned xb_add(unsigned* p, unsigned v) { return __hip_atomic_fetch_add(p, v, __ATOMIC_RELAXED, __HIP_MEMORY_SCOPE_AGENT); }
__device__ __forceinline__ unsigned xb_xcc_id() { return (unsigned)__builtin_amdgcn_s_getreg((3 << 11) | 20) & 0xFu; }
#define XB_SPIN(cond, bar) do { unsigned _sp = 0; while (cond) { __builtin_amdgcn_s_sleep(1); \
    if ((++_sp & 255u) == 0u) { if (xb_ld(&(bar)[XB_TMO])) break; if (_sp > XB_SPIN_CAP) { atomicAdd(&(bar)[XB_TMO], 1u); break; } } } } while (0)
struct XcdBarrier { unsigned* bar; unsigned x; volatile LAS unsigned* st; };
__device__ __forceinline__ XcdBarrier xcd_barrier_post(unsigned* bar, volatile LAS unsigned* st) {
    XcdBarrier b; b.bar = bar; b.x = xb_xcc_id(); b.st = st;
    if (threadIdx.x == 0) (void)xb_add(&bar[XB_XCNT(b.x)], 1u);
    return b;
}
__device__ __forceinline__ void xcd_barrier_complete(unsigned* bar, unsigned x, unsigned& nloc, unsigned& nx) {
    const unsigned G = gridDim.x * gridDim.y * gridDim.z;
    unsigned sum, cnt, mine, sp = 0u;
    for (;;) {
        sum = 0u; cnt = 0u; mine = 0u;
#pragma unroll
        for (unsigned j = 0; j < 16; ++j) { const unsigned c = xb_ld(&bar[XB_XCNT(j)]); sum += c; cnt += (c > 0u) ? 1u : 0u; mine = (j == x) ? c : mine; }
        if (sum == G) break;
        __builtin_amdgcn_s_sleep(1);
        if ((++sp & 255u) == 0u) { if (xb_ld(&bar[XB_TMO])) break; if (sp > XB_SPIN_CAP) { atomicAdd(&bar[XB_TMO], 1u); break; } }
    }
    nloc = mine > 0u ? mine : 1u; nx = cnt > 0u ? cnt : 1u;
}
__device__ __forceinline__ void xcd_barrier(const XcdBarrier& b) {
    asm volatile("s_waitcnt vmcnt(0)" ::: "memory");
    __syncthreads();
    if (threadIdx.x == 0) {
        unsigned* bar = b.bar;
        __builtin_amdgcn_s_waitcnt(0);
        unsigned nloc = b.st[0], nx = b.st[1];
        if (nloc == 0u) { xcd_barrier_complete(bar, b.x, nloc, nx); b.st[0] = nloc; b.st[1] = nx; }
        const unsigned old = xb_add(&bar[XB_XSUB(b.x)], 1u);
        const unsigned gen = old / nloc;
        if (old + 1u == (gen + 1u) * nloc) {
            __builtin_amdgcn_fence(__ATOMIC_RELEASE, "agent");
            asm volatile("s_waitcnt vmcnt(0)" ::: "memory");
            const unsigned og = xb_add(&bar[XB_TOP], 1u);
            const unsigned tg = og / nx;
            if (og + 1u == (tg + 1u) * nx) xb_add(&bar[XB_TOPGEN], 1u);
            else XB_SPIN(xb_ld(&bar[XB_TOPGEN]) == tg, bar);
            __builtin_amdgcn_fence(__ATOMIC_ACQUIRE, "agent");
            xb_add(&bar[XB_XGEN(b.x)], 1u);
            asm volatile("s_waitcnt vmcnt(0)" ::: "memory");
        } else {
            XB_SPIN(xb_ld(&bar[XB_XGEN(b.x)]) == gen, bar);
            __builtin_amdgcn_fence(__ATOMIC_ACQUIRE, "agent");
            asm volatile("s_waitcnt vmcnt(0)" ::: "memory");
        }
    }
    __syncthreads();
}

struct Frame {
    LAS unsigned char* lds;
    int tid, lane, wave, G;
    const float* in[16]; float* out; unsigned char* ws;
};

__device__ __forceinline__ int map_row(int mode, int n0) {
    if (mode == 0) return n0;
    if (mode == 1) return 256 * (n0 >> 7) + (n0 & 127);
    if (mode == 2) return 256 * (n0 >> 7) + 128 + (n0 & 127);
    if (n0 < 1024) return 2048 + n0;
    if (n0 < 2048) { const int j = n0 - 1024; return 256 * (j >> 7) + (j & 127); }
    { const int j = n0 - 2048; return 256 * (j >> 7) + 128 + (j & 127); }
}
__device__ __forceinline__ void p0_transpose_item(const float* W, int K, int N, bf16* WT, int mode, LAS float* scr, int item, int lane) {
    const int nblk = N / 32, kb = item / nblk, nb = item % nblk, k0 = 64 * kb, n0 = 32 * nb; const int drow0 = map_row(mode, n0);
#pragma unroll 8
    for (int i = 0; i < 32; ++i) { const int kk = 2 * i + (lane >> 5); scr[kk * 33 + (lane & 31)] = W[(size_t)(k0 + kk) * N + n0 + (lane & 31)]; }
    LDS_WAIT(); asm volatile("" ::: "memory");
    const int c = lane & 7;
#pragma unroll
    for (int j = 0; j < 4; ++j) { const int n = (lane >> 3) + 8 * j; const LAS float* s = scr + (8 * c) * 33 + n;
        u32x4 o; o.x = pk2(s[0 * 33], s[1 * 33]); o.y = pk2(s[2 * 33], s[3 * 33]); o.z = pk2(s[4 * 33], s[5 * 33]); o.w = pk2(s[6 * 33], s[7 * 33]);
        *(u32x4*)(WT + (size_t)(drow0 + n) * K + k0 + 8 * c) = o; }
    LDS_WAIT(); asm volatile("" ::: "memory");
}

template <int MODE>
__device__ __forceinline__ void norm_phase(const Frame& F, const float* gold, const float* gpost, const float* gpre) {
    constexpr int R = 4;
    const int lane = F.lane, c0 = 8 * lane; const int gw = blockIdx.x * NWAVES + F.wave, NGW = F.G * NWAVES;
    const bf16* MBp = (const bf16*)(F.ws + WS_MB); const float* part = (const float*)(F.ws + WS_PART); bf16* HN = (bf16*)(F.ws + WS_HN); float* RINV = (float*)(F.ws + WS_RINV);
    f32x4 gp[4], gn[4], go[4];
#pragma unroll
    for (int j = 0; j < 4; ++j) { const int c = c0 + (j >> 1) * 512 + (j & 1) * 4;
        gp[j] = (MODE != 0) ? *(const f32x4*)(gpost + c) : (f32x4){0.f, 0.f, 0.f, 0.f};
        gn[j] = (MODE != 3) ? *(const f32x4*)(gpre + c) : (f32x4){0.f, 0.f, 0.f, 0.f};
        if (MODE >= 2) { const f32x4 t = *(const f32x4*)(gold + c); go[j] = (f32x4){1.0f / t[0], 1.0f / t[1], 1.0f / t[2], 1.0f / t[3]}; } else go[j] = (f32x4){0.f, 0.f, 0.f, 0.f}; }
    for (int base = gw * R; base < M; base += NGW * R) {
        f32x4 xf[R][4]; u32x4 hr0[R], hr1[R], mr0[R], mr1[R]; float ps[R], ri[R];
#pragma unroll
        for (int r = 0; r < R; ++r) { const int row = base + r;
            if (MODE <= 1) { const float* xr = row < MP ? F.in[0] + (size_t)row * D : F.in[1] + (size_t)(row - MP) * D;
#pragma unroll
                for (int j = 0; j < 4; ++j) xf[r][j] = *(const f32x4*)(xr + c0 + (j >> 1) * 512 + (j & 1) * 4);
            } else { const bf16* hr = HN + (size_t)row * D; hr0[r] = *(const u32x4*)(hr + c0); hr1[r] = *(const u32x4*)(hr + 512 + c0); ri[r] = RINV[row]; }
            if (MODE != 0) { const bf16* mr = MBp + (size_t)row * D; mr0[r] = *(const u32x4*)(mr + c0); mr1[r] = *(const u32x4*)(mr + 512 + c0);
                ps[r] = lane < 16 ? part[(size_t)row * 16 + lane] : 0.f; } }
#pragma unroll
        for (int r = 0; r < R; ++r) { const int row = base + r;
            f32x4 x[4];
            if (MODE <= 1) {
#pragma unroll
                for (int j = 0; j < 4; ++j) x[j] = xf[r][j];
            } else { const u32x4 h0 = hr0[r], h1 = hr1[r]; const float rr = ri[r];
                x[0] = (f32x4){bflo(h0.x), bfhi(h0.x), bflo(h0.y), bfhi(h0.y)} * rr * go[0];
                x[1] = (f32x4){bflo(h0.z), bfhi(h0.z), bflo(h0.w), bfhi(h0.w)} * rr * go[1];
                x[2] = (f32x4){bflo(h1.x), bfhi(h1.x), bflo(h1.y), bfhi(h1.y)} * rr * go[2];
                x[3] = (f32x4){bflo(h1.z), bfhi(h1.z), bflo(h1.w), bfhi(h1.w)} * rr * go[3]; }
            if (MODE != 0) { const u32x4 m0 = mr0[r], m1 = mr1[r];
                const float rstd = 1.0f / sqrtf(wave_sum(ps[r]) * (1.0f / D) + EPS);
                x[0] += (f32x4){bflo(m0.x), bfhi(m0.x), bflo(m0.y), bfhi(m0.y)} * rstd * gp[0];
                x[1] += (f32x4){bflo(m0.z), bfhi(m0.z), bflo(m0.w), bfhi(m0.w)} * rstd * gp[1];
                x[2] += (f32x4){bflo(m1.x), bfhi(m1.x), bflo(m1.y), bfhi(m1.y)} * rstd * gp[2];
                x[3] += (f32x4){bflo(m1.z), bfhi(m1.z), bflo(m1.w), bfhi(m1.w)} * rstd * gp[3]; }
            if (MODE == 3) { float* orow = F.out + (size_t)row * D;
#pragma unroll
                for (int j = 0; j < 4; ++j) *(f32x4*)(orow + c0 + (j >> 1) * 512 + (j & 1) * 4) = x[j];
            } else {
                float s2 = 0.f;
#pragma unroll
                for (int j = 0; j < 4; ++j) s2 += (x[j][0] * x[j][0] + x[j][1] * x[j][1]) + (x[j][2] * x[j][2] + x[j][3] * x[j][3]);
                const float rinv = sqrtf(wave_sum(s2) * (1.0f / D) + EPS), r2 = 1.0f / rinv;
                if (lane == 0) RINV[row] = rinv;
                bf16* ho = HN + (size_t)row * D;
#pragma unroll
                for (int h = 0; h < 2; ++h) { const f32x4 a = x[2 * h] * r2 * gn[2 * h], b = x[2 * h + 1] * r2 * gn[2 * h + 1];
                    u32x4 o; o.x = pk2(a[0], a[1]); o.y = pk2(a[2], a[3]); o.z = pk2(b[0], b[1]); o.w = pk2(b[2], b[3]);
                    *(u32x4*)(ho + c0 + h * 512) = o; }
            }
        }
    }
}

__device__ __forceinline__ void convert_weights(const Frame& F, int set, int gw, int NGW) {
    LAS float* scr = (LAS float*)(F.lds + F.wave * 16384);
    constexpr int I_W1 = 16 * 48, I_SQ = 16 * 32, I_GU = 16 * 88, I_DN = 44 * 32, I_CI = 16 * 96;
    const int nitems = set == 0 ? I_W1 + I_SQ : set == 1 ? 2 * I_GU + I_DN : I_CI + I_SQ + 2 * I_GU + I_DN;
    for (int it = gw; it < nitems; it += NGW) {
        int r = it; const float* W; int K, N, mode; size_t off;
        if (set == 0) {
            if (r < I_W1) { W = F.in[3]; K = D; N = AB_IN; mode = 0; off = WS_W1; }
            else { r -= I_W1; W = F.in[9]; K = D; N = D; mode = 0; off = WS_WO0; }
        } else if (set == 1) {
            if (r < I_GU) { W = F.in[13]; K = D; N = FF; mode = 1; off = WS_WGU0; }
            else if ((r -= I_GU) < I_GU) { W = F.in[14]; K = D; N = FF; mode = 2; off = WS_WGU0; }
            else { r -= I_GU; W = F.in[15]; K = FF; N = D; mode = 0; off = WS_WD0; }
        } else {
            if (r < I_CI) { W = F.in[10]; K = D; N = CIN; mode = 3; off = WS_WCI; }
            else if ((r -= I_CI) < I_SQ) { W = F.in[12]; K = D; N = D; mode = 0; off = WS_WCO; }
            else if ((r -= I_SQ) < I_GU) { W = F.in[13] + (size_t)D * FF; K = D; N = FF; mode = 1; off = WS_WGU1; }
            else if ((r -= I_GU) < I_GU) { W = F.in[14] + (size_t)D * FF; K = D; N = FF; mode = 2; off = WS_WGU1; }
            else { r -= I_GU; W = F.in[15] + (size_t)D * FF; K = FF; N = D; mode = 0; off = WS_WD1; }
        }
        p0_transpose_item(W, K, N, (bf16*)(F.ws + off), mode, scr, r, F.lane);
    }
}
__device__ __forceinline__ void p0_prologue(const Frame& F) {
    convert_weights(F, 0, blockIdx.x * NWAVES + F.wave, F.G * NWAVES);
    bf16* WSB = (bf16*)(F.ws + WS_WSB); bf16* WPT = (bf16*)(F.ws + WS_WPT);
    for (int i = blockIdx.x * NTHR + F.tid; i < 65536; i += F.G * NTHR) {
        WSB[i] = (bf16)pk2(F.in[5][i], 0.f);
        const int g = i >> 14, d = (i >> 7) & 127, c = i & 127;
        WPT[i] = (bf16)pk2(F.in[7][(g * 128 + c) * 128 + d], 0.f);
    }
    norm_phase<0>(F, nullptr, nullptr, F.in[2]);
}

constexpr int MXS = 272;
template <bool XSWZ>
__device__ __forceinline__ void mm128(const LAS unsigned char* X, const LAS unsigned char* Y, int w, int fr, int fq, f32x4 (&acc)[8]) {
#pragma unroll
    for (int db = 0; db < 8; ++db) acc[db] = (f32x4){0.f, 0.f, 0.f, 0.f};
#pragma unroll
    for (int ks = 0; ks < 4; ++ks) {
        const bf16x8 yb = *(const LAS bf16x8*)(Y + (16 * w + fr) * MXS + ks * 64 + fq * 16);
#pragma unroll
        for (int db = 0; db < 8; ++db) { const bf16x8 xa = *(const LAS bf16x8*)(X + (db * 16 + fr) * MXS + ((ks * 64 + fq * 16) ^ (XSWZ ? (db >> 1) * 32 : 0)));
            acc[db] = __builtin_amdgcn_mfma_f32_16x16x32_bf16(xa, yb, acc[db], 0, 0, 0); }
    }
}
__device__ __forceinline__ void mixer_phase(const Frame& F) {
    LAS unsigned char* Wl = F.lds; LAS unsigned char* B0 = F.lds + 128 * MXS; LAS unsigned char* B1 = F.lds + 256 * MXS;
    const int tid = F.tid, lane = F.lane, w = F.wave, fr = lane & 15, fq = lane >> 4;
    const bf16* HC = (const bf16*)(F.ws + WS_HC); bf16* AB = (bf16*)(F.ws + WS_AB);
    const bf16* WSB = (const bf16*)(F.ws + WS_WSB); const bf16* WPT = (const bf16*)(F.ws + WS_WPT);
    const float* gv = F.in[4]; const float* bs = F.in[6]; const float* psc = F.in[8];
    constexpr int NU = (M / 128) * 8;
    const bool fixed = (F.G & 7) == 0;
    int cur_sub = -1;
    const int idx0 = blockIdx.x;
    if (idx0 >= NU) return;
    if ((idx0 & 7) < 4) {
        const int row = tid >> 2, seg = tid & 3;
        u32x4 raw[4];
        { const int chunk = idx0 >> 3, h = idx0 & 7; const bf16* vp = HC + (size_t)(chunk * 128 + row) * AB_IN + 512 + h * 128 + seg * 32;
#pragma unroll
          for (int i = 0; i < 4; ++i) raw[i] = *(const u32x4*)(vp + 8 * i); }
        int it = 0;
        for (int idx = idx0; idx < NU; idx += F.G, ++it) {
            const int chunk = idx >> 3, h = idx & 7, r0 = chunk * 128;
            LAS unsigned char* X = (it & 1) ? B1 : B0;
            if (h != cur_sub) { if (cur_sub >= 0) __syncthreads(); cur_sub = h;
#pragma unroll
                for (int i = 0; i < 4; ++i) { const int pc = tid + i * NTHR, rw = pc >> 4, c16 = pc & 15;
                    *(LAS u32x4*)(Wl + rw * MXS + c16 * 16) = *(const u32x4*)(WSB + (h * 128 + rw) * 128 + c16 * 8); } }
            { float v[32];
#pragma unroll
              for (int i = 0; i < 4; ++i) { const u32x4 rw = raw[i];
                  v[8 * i + 0] = bflo(rw.x); v[8 * i + 1] = bfhi(rw.x); v[8 * i + 2] = bflo(rw.y); v[8 * i + 3] = bfhi(rw.y);
                  v[8 * i + 4] = bflo(rw.z); v[8 * i + 5] = bfhi(rw.z); v[8 * i + 6] = bflo(rw.w); v[8 * i + 7] = bfhi(rw.w); }
              { const int nidx = idx + F.G; if (nidx < NU) { const bf16* vp = HC + (size_t)((nidx >> 3) * 128 + row) * AB_IN + 512 + (nidx & 7) * 128 + seg * 32;
#pragma unroll
                  for (int i = 0; i < 4; ++i) raw[i] = *(const u32x4*)(vp + 8 * i); } }
              float s = 0.f;
#pragma unroll
              for (int e = 0; e < 32; ++e) s += v[e];
              s += __shfl_xor(s, 1); s += __shfl_xor(s, 2); const float mu = s * (1.0f / 128.0f);
              float q = 0.f;
#pragma unroll
              for (int e = 0; e < 32; ++e) { v[e] -= mu; q += v[e] * v[e]; }
              q += __shfl_xor(q, 1); q += __shfl_xor(q, 2); const float rstd = 1.0f / sqrtf(q * (1.0f / 128.0f) + EPS);
              const float* gvp = gv + h * 128 + seg * 32;
#pragma unroll
              for (int e4 = 0; e4 < 8; ++e4) { const f32x4 g4 = *(const f32x4*)(gvp + 4 * e4);
#pragma unroll
                  for (int e = 0; e < 4; e += 2) { const int d = seg * 32 + 4 * e4 + e; const unsigned pw = pk2(v[4 * e4 + e] * rstd * g4[e], v[4 * e4 + e + 1] * rstd * g4[e + 1]);
                      *(LAS unsigned short*)(X + d * MXS + ((row * 2) ^ (seg * 32))) = (unsigned short)pw;
                      *(LAS unsigned short*)(X + (d + 1) * MXS + ((row * 2) ^ (seg * 32))) = (unsigned short)(pw >> 16); } }
            }
            const int p = 16 * w + fr; const float bias = bs[h * 128 + p];
            const bf16* up = HC + (size_t)(r0 + p) * AB_IN + h * 128 + fq * 4; bf16* op = AB + (size_t)(r0 + p) * D + h * 128 + fq * 4;
            u32x2 uu[8];
#pragma unroll
            for (int db = 0; db < 8; ++db) uu[db] = *(const u32x2*)(up + db * 16);
            __syncthreads();
            f32x4 acc[8]; mm128<true>(X, Wl, w, fr, fq, acc);
#pragma unroll
            for (int db = 0; db < 8; ++db) {
                u32x2 o; o.x = pk2(bflo(uu[db].x) * (acc[db][0] + bias), bfhi(uu[db].x) * (acc[db][1] + bias)); o.y = pk2(bflo(uu[db].y) * (acc[db][2] + bias), bfhi(uu[db].y) * (acc[db][3] + bias));
                *(u32x2*)(op + db * 16) = o; }
            if (!fixed) __syncthreads();
        }
    } else {
        u32x4 raw[5];
        auto zload = [&](int idx) {
            const int chunk = idx >> 3, gi = (idx & 7) - 4, r0 = chunk * 128, pos0 = r0 & (SEQ - 1);
#pragma unroll
            for (int k = 0; k < 5; ++k) { const int pc = tid + k * NTHR; raw[k] = (u32x4){0u, 0u, 0u, 0u};
                if (pc < 144 * 16) { const int zr = pc >> 4, c16 = pc & 15, pos = pos0 + zr - 8;
                    if (pos >= 0 && pos < SEQ) raw[k] = *(const u32x4*)(HC + (size_t)(r0 + zr - 8) * AB_IN + 1024 + gi * 128 + c16 * 8); } }
        };
        zload(idx0);
        for (int idx = idx0; idx < NU; idx += F.G) {
            const int chunk = idx >> 3, gi = (idx & 7) - 4, r0 = chunk * 128, hh = 1 << gi, pos0 = r0 & (SEQ - 1);
            if (gi != cur_sub) { cur_sub = gi;
#pragma unroll
                for (int i = 0; i < 4; ++i) { const int pc = tid + i * NTHR, rw = pc >> 4, c16 = pc & 15;
                    *(LAS u32x4*)(Wl + rw * MXS + c16 * 16) = *(const u32x4*)(WPT + (gi * 128 + rw) * 128 + c16 * 8); } }
#pragma unroll
            for (int k = 0; k < 5; ++k) { const int pc = tid + k * NTHR; if (pc < 144 * 16) *(LAS u32x4*)(B1 + (pc >> 4) * MXS + (pc & 15) * 16) = raw[k]; }
            __syncthreads();
            { const int nidx = idx + F.G; if (nidx < NU) zload(nidx); }
            {
              const int cgb = (tid & 15) * 16, i0 = (tid >> 4) * 4;
              float s[8];
#pragma unroll
              for (int e = 0; e < 8; ++e) s[e] = 0.f;
              for (int j = -hh; j < hh; ++j) { const u32x4 rw = *(const LAS u32x4*)(B1 + (i0 + 8 + j) * MXS + cgb);
                  s[0] += bflo(rw.x); s[1] += bfhi(rw.x); s[2] += bflo(rw.y); s[3] += bfhi(rw.y); s[4] += bflo(rw.z); s[5] += bfhi(rw.z); s[6] += bflo(rw.w); s[7] += bfhi(rw.w); }
#pragma unroll
              for (int k = 0; k < 4; ++k) { const int i = i0 + k, pos = pos0 + i;
                  if (k > 0) { const u32x4 ra = *(const LAS u32x4*)(B1 + (i + 7 + hh) * MXS + cgb), rs = *(const LAS u32x4*)(B1 + (i + 7 - hh) * MXS + cgb);
                      s[0] += bflo(ra.x) - bflo(rs.x); s[1] += bfhi(ra.x) - bfhi(rs.x); s[2] += bflo(ra.y) - bflo(rs.y); s[3] += bfhi(ra.y) - bfhi(rs.y);
                      s[4] += bflo(ra.z) - bflo(rs.z); s[5] += bfhi(ra.z) - bfhi(rs.z); s[6] += bflo(ra.w) - bflo(rs.w); s[7] += bfhi(ra.w) - bfhi(rs.w); }
                  const int hi = (pos + hh < SEQ) ? pos + hh : SEQ, lo = (pos - hh > 0) ? pos - hh : 0; const float inv = 1.0f / (float)(hi - lo);
                  const u32x4 zc = *(const LAS u32x4*)(B1 + (i + 8) * MXS + cgb);
                  u32x4 o; o.x = pk2(s[0] * inv - bflo(zc.x), s[1] * inv - bfhi(zc.x)); o.y = pk2(s[2] * inv - bflo(zc.y), s[3] * inv - bfhi(zc.y));
                  o.z = pk2(s[4] * inv - bflo(zc.z), s[5] * inv - bfhi(zc.z)); o.w = pk2(s[6] * inv - bflo(zc.w), s[7] * inv - bfhi(zc.w));
                  *(LAS u32x4*)(B0 + i * MXS + cgb) = o; }
            }
            __syncthreads();
            f32x4 acc[8]; mm128<false>(Wl, B0, w, fr, fq, acc);
            const int i = 16 * w + fr; const float* pp = psc + gi * 128 + fq * 4; bf16* op = AB + (size_t)(r0 + i) * D + 512 + gi * 128 + fq * 4;
#pragma unroll
            for (int db = 0; db < 8; ++db) { const f32x4 sc = *(const f32x4*)(pp + db * 16); const f32x4 r = acc[db] * sc;
                u32x2 o; o.x = pk2(r[0], r[1]); o.y = pk2(r[2], r[3]); *(u32x2*)(op + db * 16) = o; }
            if (!fixed) __syncthreads();
        }
    }
    __syncthreads();
}

__device__ __forceinline__ void conv_phase(const Frame& F) {
    const bf16* T = (const bf16*)(F.ws + WS_T); const bf16* GB = (const bf16*)(F.ws + WS_GB); bf16* CV = (bf16*)(F.ws + WS_GB);
    const float* cw = F.in[11];
    constexpr int R = 4;
    const int c8 = (F.tid & 127) * 8, rsub = F.tid >> 7;
    const f32x4 w0a = *(const f32x4*)(cw + c8), w0b = *(const f32x4*)(cw + c8 + 4), w1a = *(const f32x4*)(cw + D + c8), w1b = *(const f32x4*)(cw + D + c8 + 4),
                w2a = *(const f32x4*)(cw + 2 * D + c8), w2b = *(const f32x4*)(cw + 2 * D + c8 + 4);
    const u32x4 z4 = (u32x4){0u, 0u, 0u, 0u};
    for (int rb = blockIdx.x * 16; rb < M; rb += F.G * 16) {
        const int r0 = rb + rsub * R; const int pos0 = r0 & (SEQ - 1);
        const size_t o0 = (size_t)r0 * D + c8;
        u32x4 t[R + 2], gb[R];
        t[0] = pos0 > 0 ? *(const u32x4*)(T + o0 - D) : z4;
#pragma unroll
        for (int k = 0; k < R; ++k) { t[k + 1] = *(const u32x4*)(T + o0 + (size_t)k * D); gb[k] = *(const u32x4*)(GB + o0 + (size_t)k * D); }
        t[R + 1] = (pos0 + R < SEQ) ? *(const u32x4*)(T + o0 + (size_t)R * D) : z4;
#pragma unroll
        for (int k = 0; k < R; ++k) { const u32x4 t0 = t[k], t1 = t[k + 1], t2 = t[k + 2], g = gb[k];
            const f32x4 a0 = (f32x4){bflo(t0.x), bfhi(t0.x), bflo(t0.y), bfhi(t0.y)}, b0 = (f32x4){bflo(t0.z), bfhi(t0.z), bflo(t0.w), bfhi(t0.w)};
            const f32x4 a1 = (f32x4){bflo(t1.x), bfhi(t1.x), bflo(t1.y), bfhi(t1.y)}, b1 = (f32x4){bflo(t1.z), bfhi(t1.z), bflo(t1.w), bfhi(t1.w)};
            const f32x4 a2 = (f32x4){bflo(t2.x), bfhi(t2.x), bflo(t2.y), bfhi(t2.y)}, b2 = (f32x4){bflo(t2.z), bfhi(t2.z), bflo(t2.w), bfhi(t2.w)};
            const f32x4 ga = (f32x4){bflo(g.x), bfhi(g.x), bflo(g.y), bfhi(g.y)}, gbb = (f32x4){bflo(g.z), bfhi(g.z), bflo(g.w), bfhi(g.w)};
            const f32x4 ra = ga * (a0 * w0a + a1 * w1a + a2 * w2a), rb2 = gbb * (b0 * w0b + b1 * w1b + b2 * w2b);
            u32x4 ov; ov.x = pk2(ra[0], ra[1]); ov.y = pk2(ra[2], ra[3]); ov.z = pk2(rb2[0], rb2[1]); ov.w = pk2(rb2[2], rb2[3]);
            *(u32x4*)(CV + o0 + (size_t)k * D) = ov; }
    }
}

struct Args { const float* in[16]; float* out; unsigned char* ws; };
__global__ void __launch_bounds__(NTHR, 2) mk_fwd(Args args) {
    extern __shared__ __attribute__((aligned(16))) unsigned char lds_raw[];
    cg::grid_group grid = cg::this_grid();
    Frame F;
    F.lds = (LAS unsigned char*)lds_raw;
    F.tid = threadIdx.x; F.lane = F.tid & 63; F.wave = __builtin_amdgcn_readfirstlane(F.tid >> 6); F.G = gridDim.x;
#pragma unroll
    for (int i = 0; i < 16; ++i) F.in[i] = args.in[i];
    F.out = args.out; F.ws = args.ws;
    unsigned char* ws = args.ws;
    bf16* HN = (bf16*)(ws + WS_HN); bf16* MB = (bf16*)(ws + WS_MB); bf16* HF = (bf16*)(ws + WS_HF); float* PART = (float*)(ws + WS_PART);
    const float* ng = F.in[2];
    const int bid = (int)blockIdx.x;

    volatile LAS unsigned* bst = (volatile LAS unsigned*)(F.lds + LDS_BYTES - 64);
    if (F.tid < 16) bst[F.tid] = 0u;
    __syncthreads();
    unsigned* barw = (unsigned*)ws;
    const XcdBarrier xbar = xcd_barrier_post(barw, bst);
    if (args.ws == nullptr) grid.sync();
    p0_prologue(F);
#define GRID_BAR() xcd_barrier(xbar)
    GRID_BAR();
    { pg8::Gemm g{HN, (const bf16*)(ws + WS_W1), M, AB_IN, D}; pg8::StaticOrder S; S.init(M, AB_IN, F.G, bid);
      pg8::EpiAct E{(bf16*)(ws + WS_HC), AB_IN, 4};
      pg8::gemm_phase<pg8::EpiAct, pg8::StaticOrder, true, true>(F.lds, g, S, E); }
    { const int nfull = ((M / 256) * (AB_IN / 256)) % F.G;
      if (nfull == 0) convert_weights(F, 1, bid * NWAVES + F.wave, F.G * NWAVES);
      else if (bid >= nfull) convert_weights(F, 1, (bid - nfull) * NWAVES + F.wave, (F.G - nfull) * NWAVES); }
    GRID_BAR();
    mixer_phase(F);
    GRID_BAR();
    { pg8::Gemm g{(const bf16*)(ws + WS_AB), (const bf16*)(ws + WS_WO0), M, D, D}; pg8::StaticOrder S; S.init(M, D, F.G, bid);
      pg8::EpiStats E{MB, PART};
      pg8::gemm_phase<pg8::EpiStats, pg8::StaticOrder, true, true>(F.lds, g, S, E); }
    GRID_BAR();
    norm_phase<2>(F, ng + 0 * D, ng + 1 * D, ng + 2 * D);
    GRID_BAR();
    { pg8::Gemm g{HN, (const bf16*)(ws + WS_WGU0), M, 2 * FF, D}; pg8::StaticOrder S; S.init(M, 2 * FF, F.G, bid);
      pg8::EpiSwiglu E{HF, FF};
      pg8::gemm_phase<pg8::EpiSwiglu, pg8::StaticOrder, true, true>(F.lds, g, S, E); }
    { const int nfull = ((M / 256) * (2 * FF / 256)) % F.G;
      if (nfull == 0) convert_weights(F, 2, bid * NWAVES + F.wave, F.G * NWAVES);
      else if (bid >= nfull) convert_weights(F, 2, (bid - nfull) * NWAVES + F.wave, (F.G - nfull) * NWAVES); }
    GRID_BAR();
    { pg8::Gemm g{HF, (const bf16*)(ws + WS_WD0), M, D, FF}; pg8::StaticOrder S; S.init(M, D, F.G, bid);
      pg8::EpiStats E{MB, PART};
      pg8::gemm_phase<pg8::EpiStats, pg8::StaticOrder, true, true>(F.lds, g, S, E); }
    GRID_BAR();
    norm_phase<2>(F, ng + 2 * D, ng + 3 * D, ng + 4 * D);
    GRID_BAR();
    { pg8::Gemm g{HN, (const bf16*)(ws + WS_WCI), M, CIN, D}; pg8::StaticOrder S; S.init(M, CIN, F.G, bid);
      pg8::EpiMulSplit E{(bf16*)(ws + WS_T), (bf16*)(ws + WS_GB)};
      pg8::gemm_phase<pg8::EpiMulSplit, pg8::StaticOrder, true, true>(F.lds, g, S, E); }
    GRID_BAR();
    conv_phase(F);
    GRID_BAR();
    { pg8::Gemm g{(const bf16*)(ws + WS_GB), (const bf16*)(ws + WS_WCO), M, D, D}; pg8::StaticOrder S; S.init(M, D, F.G, bid);
      pg8::EpiStats E{MB, PART};
      pg8::gemm_phase<pg8::EpiStats, pg8::StaticOrder, true, true>(F.lds, g, S, E); }
    GRID_BAR();
    norm_phase<2>(F, ng + 4 * D, ng + 5 * D, ng + 6 * D);
    GRID_BAR();
    { pg8::Gemm g{HN, (const bf16*)(ws + WS_WGU1), M, 2 * FF, D}; pg8::StaticOrder S; S.init(M, 2 * FF, F.G, bid);
      pg8::EpiSwiglu E{HF, FF};
      pg8::gemm_phase<pg8::EpiSwiglu, pg8::StaticOrder, true, true>(F.lds, g, S, E); }
    GRID_BAR();
    { pg8::Gemm g{HF, (const bf16*)(ws + WS_WD1), M, D, FF}; pg8::StaticOrder S; S.init(M, D, F.G, bid);
      pg8::EpiStats E{MB, PART};
      pg8::gemm_phase<pg8::EpiStats, pg8::StaticOrder, true, true>(F.lds, g, S, E); }
    GRID_BAR();
    norm_phase<3>(F, ng + 6 * D, ng + 7 * D, nullptr);
}

extern "C" void kernel_launch(void* const* d_in, const int* in_sizes, int n_in, void* d_out, int out_size, void* d_ws, size_t ws_size, hipStream_t stream) {
    static int grid = 0;
    if (grid == 0) {
        if (n_in != 16 || out_size != M * D || ws_size < WS_END) { fprintf(stderr, "kernel_launch: unexpected shapes (n_in %d, out %d, ws %zu); nothing launched\n", n_in, out_size, ws_size); grid = -1; return; }
        int dev = 0, cus = 0, per_cu = 0;
        if (hipGetDevice(&dev) != hipSuccess || hipDeviceGetAttribute(&cus, hipDeviceAttributeMultiprocessorCount, dev) != hipSuccess) { grid = -1; return; }
        if (hipFuncSetAttribute((const void*)mk_fwd, hipFuncAttributeMaxDynamicSharedMemorySize, LDS_BYTES) != hipSuccess) { fprintf(stderr, "kernel_launch: hipFuncSetAttribute failed\n"); grid = -1; return; }
        if (hipOccupancyMaxActiveBlocksPerMultiprocessor(&per_cu, (const void*)mk_fwd, NTHR, LDS_BYTES) != hipSuccess || per_cu < 1) { fprintf(stderr, "kernel_launch: occupancy query says %d\n", per_cu); per_cu = 1; }
        (void)hipGetLastError();
        grid = cus - (cus % 8);
    }
    if (grid < 0) return;
    if (hipMemsetAsync(d_ws, 0, XCD_BAR_WORDS * 4, stream) != hipSuccess) { fprintf(stderr, "kernel_launch: memset failed\n"); return; }
    Args a{};
    for (int i = 0; i < 16; ++i) a.in[i] = (const float*)d_in[i];
    a.out = (float*)d_out; a.ws = (unsigned char*)d_ws;
    void* kargs[] = {&a};
    hipError_t e = hipLaunchCooperativeKernel((const void*)mk_fwd, dim3(grid), dim3(NTHR), kargs, LDS_BYTES, stream);
    if (e != hipSuccess) fprintf(stderr, "kernel_launch: cooperative launch failed: %s (grid %d)\n", hipGetErrorString(e), grid);
}
```
